# Optimizing an MI355X kernel written in HIP

```python
import jax, jax.numpy as jnp
from jax import lax
import numpy as np

D_MODEL = 1024
BATCH = 8
SEQ = 4096
DEPTH = 4

N_A = DEPTH // 2
N_B = DEPTH - N_A
PLE_DIM = 256
NORM_EPS = 1e-6
RW_HEAD = 64
RW_WIDTH = D_MODEL
RW_HEADS = RW_WIDTH // RW_HEAD
DECAY_LORA = 64
AAA_LORA = 64
MV_LORA = 32
GN_EPS = 64e-5
ATT_HEAD = 128
KV_HEADS = 8
ATT_WIDTH = KV_HEADS * ATT_HEAD
DILATION_GROUPS = ((128, 1), (512, 4), (2048, 16))
N_GROUPS = len(DILATION_GROUPS)
Q_WIDTH = N_GROUPS * ATT_WIDTH
BLOCK = 128

kernel_name = "yoco_rwkv7_dilated_alibi_hybrid"


def rmsnorm(x, g):
    xf = x.astype(jnp.float32)
    y = xf * lax.rsqrt(jnp.mean(xf * xf, axis=-1, keepdims=True) + NORM_EPS)
    return (y * g.astype(jnp.float32)).astype(x.dtype)


def token_shift(x):
    return jnp.pad(x, ((0, 0), (1, 0), (0, 0)))[:, :-1]


def wkv7(r, decay, k, v, kk, a):
    B, S, H, N = r.shape

    def step(state, inp):
        r_t, w_t, k_t, v_t, kk_t, a_t = inp
        sa = jnp.einsum('bhij,bhj->bhi', state, -kk_t)
        state = (state * w_t[:, :, None, :]
                 + sa[..., None] * (kk_t * a_t)[:, :, None, :]
                 + v_t[..., None] * k_t[:, :, None, :])
        return state, jnp.einsum('bhij,bhj->bhi', state, r_t)

    seq = tuple(jnp.moveaxis(t, 1, 0) for t in (r, decay, k, v, kk, a))
    s0 = jnp.zeros((B, H, N, N), jnp.float32)
    _, y = lax.scan(step, s0, seq)
    return jnp.moveaxis(y, 0, 1)


def rwkv7_time_mix(x, v_first, mu, w_rkvg, w0, w1, w2, a0, a1, a2, vres,
                   k_k, k_a, r_k, gn_g, gn_b, w_o):
    f32 = jnp.float32
    B, S, _ = x.shape
    xx = token_shift(x) - x
    xm = x[None] + xx[None] * mu[:, None, None, :]
    r, k, v, gate = jnp.einsum('nbsd,nde->nbse', xm[:4], w_rkvg)
    w_log = -jax.nn.softplus(-(w0 + jnp.tanh(xm[4] @ w1) @ w2).astype(f32)) - 0.5
    decay = jnp.exp(-jnp.exp(w_log))
    a = jax.nn.sigmoid((a0 + (xm[5] @ a1) @ a2).astype(f32))
    if vres is not None:
        v0, v1, v2 = vres
        v = v + (v_first - v) * jax.nn.sigmoid(v0 + (xm[2] @ v1) @ v2)

    def heads(t):
        return t.astype(f32).reshape(B, S, RW_HEADS, RW_HEAD)

    kk = heads(k * k_k)
    kk = kk / jnp.maximum(jnp.sqrt(jnp.sum(kk * kk, axis=-1, keepdims=True)), 1e-12)
    k = k * (1.0 + (a - 1.0) * k_a)
    rh, kh, vh = heads(r), heads(k), heads(v)
    y = wkv7(rh, heads(decay), kh, vh, kk, heads(a))
    mean = jnp.mean(y, axis=-1, keepdims=True)
    yc = y - mean
    y = yc * lax.rsqrt(jnp.mean(yc * yc, axis=-1, keepdims=True) + GN_EPS)
    y = y.reshape(B, S, RW_WIDTH) * gn_g + gn_b
    y = y + (jnp.sum(rh * kh * r_k, axis=-1, keepdims=True) * vh).reshape(B, S, RW_WIDTH)
    out = (y * jax.nn.silu(gate.astype(f32))) @ w_o
    return out.astype(x.dtype), v


def to_strided_blocks(t, d):
    B, S, H, E = t.shape
    n = S // d
    nb = -(-n // BLOCK)
    t = t.reshape(B, n, d, H, E).transpose(0, 2, 1, 3, 4)
    t = jnp.pad(t, ((0, 0), (0, 0), (0, nb * BLOCK - n), (0, 0), (0, 0)))
    return t.reshape(B, d, nb, BLOCK, H, E)


def from_strided_blocks(t, S):
    B, d, nb, L = t.shape[:4]
    rest = t.shape[4:]
    n = S // d
    t = t.reshape((B, d, nb * L) + rest)[:, :, :n]
    t = jnp.moveaxis(t, 1, 2)
    return t.reshape((B, S) + rest)


def with_prev_block(t):
    prev = jnp.pad(t, ((0, 0), (0, 0), (1, 0), (0, 0), (0, 0), (0, 0)))[:, :, :-1]
    return jnp.concatenate([prev, t], axis=3)


def alibi_slopes(d):
    h = np.arange(1, KV_HEADS + 1, dtype=np.float32)
    return jnp.asarray((2.0 ** (-8.0 * h / KV_HEADS)) / d, dtype=jnp.float32)


def shared_kv_windows(h, kv_ln_g, w_kv):
    B, S, _ = h.shape
    kv = rmsnorm(h, kv_ln_g) @ w_kv
    k = kv[..., :ATT_WIDTH].reshape(B, S, KV_HEADS, ATT_HEAD)
    v = kv[..., ATT_WIDTH:].reshape(B, S, KV_HEADS, ATT_HEAD)
    return tuple((with_prev_block(to_strided_blocks(k, d)), with_prev_block(to_strided_blocks(v, d)))
                 for (_, d) in DILATION_GROUPS)


def dilated_group_attention(q, kw, vw, d, span, slopes):
    S = q.shape[1]
    qb = to_strided_blocks(q, d)
    nb = qb.shape[2]
    s = jnp.einsum('brcihe,brcjhe->brchij', qb, kw).astype(jnp.float32) * (ATT_HEAD ** -0.5)
    i = jnp.arange(BLOCK)[:, None]
    j = jnp.arange(2 * BLOCK)[None, :]
    delta = BLOCK + i - j
    c = jnp.arange(nb)[:, None, None]
    valid = (delta >= 0) & (delta <= span) & (c * BLOCK + j - BLOCK >= 0)
    bias = -slopes[:, None, None] * (delta * d).astype(jnp.float32)[None]
    s = jnp.where(valid[:, None], s + bias, -jnp.inf)
    m = jnp.max(s, axis=-1, keepdims=True)
    pexp = jnp.exp(s - m)
    l = jnp.sum(pexp, axis=-1, keepdims=True)
    o = jnp.einsum('brchij,brcjhe->brcihe', pexp / l, vw)
    lse = jnp.moveaxis((m + jnp.log(l))[..., 0], -1, -2)
    return from_strided_blocks(o, S), from_strided_blocks(lse, S)


def dilated_attention_mix(x, kv_windows, w_in, w_o):
    B, S, _ = x.shape
    proj = x @ w_in
    q = proj[..., :Q_WIDTH].reshape(B, S, N_GROUPS, KV_HEADS, ATT_HEAD)
    gate = proj[..., Q_WIDTH:]
    outs, lses = [], []
    for g, (window, d) in enumerate(DILATION_GROUPS):
        kw, vw = kv_windows[g]
        o, lse = dilated_group_attention(q[:, :, g], kw, vw, d, window // d, alibi_slopes(d))
        outs.append(o)
        lses.append(lse)
    alpha = jax.nn.softmax(jnp.stack(lses), axis=0)
    o = jnp.einsum('gbsh,gbshe->bshe', alpha, jnp.stack(outs)).reshape(B, S, ATT_WIDTH)
    return ((o * jax.nn.silu(gate.astype(jnp.float32))) @ w_o).astype(x.dtype)


def per_layer_embedding(h, p_i, w_p, gate_ln_g, w_gate):
    gate = jax.nn.sigmoid((rmsnorm(h, gate_ln_g) @ w_gate).astype(jnp.float32))
    return ((p_i @ w_p) * gate).astype(h.dtype)


def setup_inputs(seed: int = 0) -> dict:
    key = jax.random.key(seed)
    ks = iter(jax.random.split(key, 40))
    D = D_MODEL
    na1 = N_A - 1

    def nrm(shape, scale):
        return scale * jax.random.normal(next(ks), shape, jnp.float32)

    def gain(shape):
        return 1.0 + nrm(shape, 0.02)

    return {
        "x": nrm((BATCH, SEQ, D), 1.0),
        "p": nrm((DEPTH, BATCH, SEQ, PLE_DIM), 1.0),
        "a_ln_g": gain((N_A, D)),
        "a_mu": jax.random.uniform(next(ks), (N_A, 6, D), jnp.float32),
        "a_w_rkvg": nrm((N_A, 4, D, RW_WIDTH), D ** -0.5),
        "a_w0": jax.random.uniform(next(ks), (N_A, RW_WIDTH), jnp.float32, -6.0, 1.0),
        "a_w1": nrm((N_A, D, DECAY_LORA), D ** -0.5),
        "a_w2": nrm((N_A, DECAY_LORA, RW_WIDTH), 0.3 * DECAY_LORA ** -0.5),
        "a_a0": nrm((N_A, RW_WIDTH), 0.5),
        "a_a1": nrm((N_A, D, AAA_LORA), D ** -0.5),
        "a_a2": nrm((N_A, AAA_LORA, RW_WIDTH), 0.5 * AAA_LORA ** -0.5),
        "a_v0": 1.0 + nrm((na1, RW_WIDTH), 0.1),
        "a_v1": nrm((na1, D, MV_LORA), D ** -0.5),
        "a_v2": nrm((na1, MV_LORA, RW_WIDTH), 0.5 * MV_LORA ** -0.5),
        "a_k_k": 0.85 + nrm((N_A, RW_WIDTH), 0.05),
        "a_k_a": 1.0 + nrm((N_A, RW_WIDTH), 0.05),
        "a_r_k": nrm((N_A, RW_HEADS, RW_HEAD), 0.1),
        "a_gn_g": gain((N_A, RW_WIDTH)),
        "a_gn_b": nrm((N_A, RW_WIDTH), 0.02),
        "a_w_o": nrm((N_A, RW_WIDTH, D), 0.5 * RW_WIDTH ** -0.5),
        "kv_ln_g": gain((D,)),
        "w_kv": nrm((D, 2 * ATT_WIDTH), D ** -0.5),
        "b_ln_g": gain((N_B, D)),
        "b_w_in": nrm((N_B, D, Q_WIDTH + ATT_WIDTH), D ** -0.5),
        "b_w_o": nrm((N_B, ATT_WIDTH, D), 0.5 * ATT_WIDTH ** -0.5),
        "ple_w": nrm((DEPTH, PLE_DIM, D), 0.5 * PLE_DIM ** -0.5),
        "ple_gate_ln_g": gain((DEPTH, D)),
        "ple_w_gate": nrm((DEPTH, D, D), D ** -0.5),
        "final_ln_g": gain((D,)),
    }


def reference(x, p, a_ln_g, a_mu, a_w_rkvg, a_w0, a_w1, a_w2, a_a0, a_a1, a_a2,
              a_v0, a_v1, a_v2, a_k_k, a_k_a, a_r_k, a_gn_g, a_gn_b, a_w_o,
              kv_ln_g, w_kv, b_ln_g, b_w_in, b_w_o,
              ple_w, ple_gate_ln_g, ple_w_gate, final_ln_g):
    h = x
    v_first = None
    kv_windows = None
    for i in range(DEPTH):
        if i < N_A:
            vres = None if i == 0 else (a_v0[i - 1], a_v1[i - 1], a_v2[i - 1])
            mix, v = rwkv7_time_mix(rmsnorm(h, a_ln_g[i]), v_first, a_mu[i], a_w_rkvg[i],
                                    a_w0[i], a_w1[i], a_w2[i], a_a0[i], a_a1[i], a_a2[i], vres,
                                    a_k_k[i], a_k_a[i], a_r_k[i], a_gn_g[i], a_gn_b[i], a_w_o[i])
            if i == 0:
                v_first = v
        else:
            j = i - N_A
            mix = dilated_attention_mix(rmsnorm(h, b_ln_g[j]), kv_windows, b_w_in[j], b_w_o[j])
        h = h + mix
        h = h + per_layer_embedding(h, p[i], ple_w[i], ple_gate_ln_g[i], ple_w_gate[i])
        if i == N_A - 1:
            kv_windows = shared_kv_windows(h, kv_ln_g, w_kv)
    return rmsnorm(h, final_ln_g)
```

```cpp
#include <hip/hip_runtime.h>
#include <hip/hip_cooperative_groups.h>
#include <cstdio>
namespace cg = cooperative_groups;

#define LAS __attribute__((address_space(3)))
typedef unsigned short bf16_t;
typedef short bf16x8 __attribute__((ext_vector_type(8)));
typedef short s16x4 __attribute__((ext_vector_type(4)));
typedef float f32x4 __attribute__((ext_vector_type(4)));
typedef unsigned u32x4 __attribute__((ext_vector_type(4)));
typedef unsigned u32x2 __attribute__((ext_vector_type(2)));

constexpr int T_TOK = 32768, DM = 1024, SEQ = 4096;
constexpr size_t ARR_E = (size_t)T_TOK * DM;
constexpr size_t MiB = 1048576;
constexpr size_t WS_W = 0, WS_BAR = 60 * MiB, WS_SSQ = 60 * MiB + 65536, WS_ARR = 62 * MiB, WS_P = 446 * MiB, WS_L = 462 * MiB, WS_LSE = 462 * MiB, ARR_B = 64 * MiB;
constexpr size_t WS_A6 = 446 * MiB;
constexpr int LDS_BYTES = 139264;
constexpr int NPH = 31;
constexpr int LP = 192;
constexpr int PROBE_MODE = 0;
constexpr size_t RW_STRIDE = 6815744, RW_WRK = 0, RW_WVW = 2097152, RW_WA1 = 3670016, RW_W2C = 3932160, RW_WG = 4718592, RW_WO = 5767168;
constexpr size_t PLE_BASE = 13631488, PLE_STRIDE = 1310720, PLE_WP = 1048576;
constexpr size_t KV_BASE = 18874368, ATT_BASE = 20971520, ATT_STRIDE = 5242880, ATT_WO = 4194304;

struct Params {
    const float* in[29];
    float* out;
    unsigned char* ws;
    int ph_lo, ph_hi;
};

typedef const __attribute__((address_space(4))) Params* PP;

typedef __bf16 bf16x2_t __attribute__((ext_vector_type(2)));
typedef float f32x2_t __attribute__((ext_vector_type(2)));
__device__ __forceinline__ unsigned cvt_pk_bf16(float lo, float hi) { const f32x2_t v = {lo, hi}; return __builtin_bit_cast(unsigned, __builtin_convertvector(v, bf16x2_t)); }
__device__ __forceinline__ float bf_lo(unsigned u) { return __uint_as_float(u << 16); }
__device__ __forceinline__ float bf_hi(unsigned u) { return __uint_as_float(u & 0xffff0000u); }
__device__ __forceinline__ float sigmoidf_(float z) { return __builtin_amdgcn_rcpf(1.0f + __builtin_amdgcn_exp2f(-1.4426950408889634f * z)); }
__device__ __forceinline__ float siluf_(float z) { return z * __builtin_amdgcn_rcpf(1.0f + __builtin_amdgcn_exp2f(-1.4426950408889634f * z)); }
__device__ __forceinline__ float dpp_xor1(float v) { return __builtin_bit_cast(float, __builtin_amdgcn_update_dpp(0, __builtin_bit_cast(int, v), 0xB1, 0xf, 0xf, false)); }
__device__ __forceinline__ float dpp_xor2(float v) { return __builtin_bit_cast(float, __builtin_amdgcn_update_dpp(0, __builtin_bit_cast(int, v), 0x4E, 0xf, 0xf, false)); }
__device__ __forceinline__ float dpp_hmir(float v) { return __builtin_bit_cast(float, __builtin_amdgcn_update_dpp(0, __builtin_bit_cast(int, v), 0x141, 0xf, 0xf, false)); }
__device__ __forceinline__ float dpp_mir(float v) { return __builtin_bit_cast(float, __builtin_amdgcn_update_dpp(0, __builtin_bit_cast(int, v), 0x140, 0xf, 0xf, false)); }
__device__ __forceinline__ float sum16d(float v) { v += dpp_xor1(v); v += dpp_xor2(v); v += dpp_hmir(v); v += dpp_mir(v); return v; }
__device__ __forceinline__ float wave_sum(float v) {
#pragma unroll
    for (int o = 32; o >= 1; o >>= 1) v += __shfl_xor(v, o, 64);
    return v;
}
__device__ __forceinline__ float sum16(float v) {
    v += __shfl_xor(v, 1, 64); v += __shfl_xor(v, 2, 64); v += __shfl_xor(v, 4, 64); v += __shfl_xor(v, 8, 64); return v;
}

namespace pg8 {
constexpr int BM = 256, BK = 64, HALF = 128, HTB = HALF * BK * 2, NXCD = 8, WGM = 8;
__device__ __forceinline__ int lds_byte(int r, int c) { const int st = (r >> 4) * 2 + (c >> 5), rr = r & 15, cc = c & 31, ob = rr * 64 + cc * 2; return st * 1024 + (ob ^ (((ob >> 9) & 1) << 5)); }
__device__ __forceinline__ void stage_rc(int b, int& R, int& C) { const int st = b / 1024, sb = b % 1024, swz = sb ^ (((sb >> 9) & 1) << 5); R = (st >> 1) * 16 + swz / 64; C = (st & 1) * 32 + (swz % 64) / 2; }
__device__ __forceinline__ int perm32(int rho) { const int n = rho >> 4, i = rho & 15; return 8 * (i >> 2) + 4 * n + (i & 3); }
struct Unit { int pm, pn; };
struct Gemm { const bf16_t* A; const bf16_t* Bt; int K; };

struct SegOrder {
    int nseg, G, c;
    int pm1, pn1, pm2, pn2, nN0, nN1, nN2;
    __device__ __forceinline__ bool next(int i, Unit& u) const {
        int L = i * G + c;
        int s = 0;
        const int u0 = 128 * nN0, u1 = 128 * nN1;
        if (L >= u0) { if (nseg < 2) return false; L -= u0; s = 1;
            if (L >= u1) { if (nseg < 3) return false; L -= u1; s = 2; if (L >= 128 * nN2) return false; } }
        const int nM = 128, nn = (s == 0) ? nN0 : (s == 1 ? nN1 : nN2), nwg = nM * nn;
        int wgid = L; { const int q = nwg / NXCD, r = nwg % NXCD, xcd = wgid % NXCD, off = wgid / NXCD; wgid = (xcd < r ? xcd * (q + 1) : r * (q + 1) + (xcd - r) * q) + off; }
        const int nig = WGM * nn, gid = wgid / nig, fm = gid * WGM, gsz = (nM - fm) < WGM ? (nM - fm) : WGM;
        u.pm = ((s == 0) ? 0 : (s == 1 ? pm1 : pm2)) + fm + ((wgid % nig) % gsz); u.pn = ((s == 0) ? 0 : (s == 1 ? pn1 : pn2)) + (wgid % nig) / gsz; return true;
    }
};

template <class Epi, class Sched>
__device__ __forceinline__ void gemm_phase(LAS unsigned char* lds, const Gemm g, const Sched& S, const Epi& E, int tid_) {
    const int tid = tid_, wid = __builtin_amdgcn_readfirstlane(tid >> 6), lane = tid & 63, wr = wid >> 2, wc = wid & 3, fr = lane & 15, fq = lane >> 4;
    const int K = g.K, nt = K / BK;
    unsigned voffA[2], voffB[2];
#pragma unroll
    for (int i = 0; i < 2; ++i) { int R, C; stage_rc(tid * 16 + i * 8192, R, C); const int Rb = Epi::PERM ? ((R & ~31) + perm32(R & 31)) : R;
        voffA[i] = (unsigned)(R * K + C) * 2u; voffB[i] = (unsigned)(Rb * K + C) * 2u; }
    const size_t kstep = (size_t)(BK * 2);
    const size_t hstep = (size_t)HALF * K * 2;
    const size_t tstep = 2 * hstep;
    const unsigned ldsw = (unsigned)wid * 1024u;
    const int aoff = lds_byte(wr * 64 + fr, fq * 8), boff = lds_byte(wc * 32 + fr, fq * 8);
#define PG8_SA(b, h) (((b) * 2 + (h)) * HTB)
#define PG8_SB(b, h) ((4 + (b) * 2 + (h)) * HTB)
#define PG8_STAGE(bufoff, gbase, voff) do { _Pragma("unroll") for (int _i = 0; _i < 2; ++_i) \
        __builtin_amdgcn_global_load_lds((const unsigned*)((const char*)(gbase) + (voff)[_i]), (LAS unsigned*)(lds + (bufoff) + ldsw + _i * 8192), 16, 0, 0); } while (0)
#define PG8_LDA(dst, b, h) do { _Pragma("unroll") for (int m = 0; m < 4; ++m) _Pragma("unroll") for (int k = 0; k < 2; ++k) dst[m][k] = *(const LAS bf16x8*)(lds + PG8_SA(b, h) + aoff + m * 2048 + k * 1024); } while (0)
#define PG8_LDB(dst, b, h) do { _Pragma("unroll") for (int n = 0; n < 2; ++n) _Pragma("unroll") for (int k = 0; k < 2; ++k) dst[n][k] = *(const LAS bf16x8*)(lds + PG8_SB(b, h) + boff + n * 2048 + k * 1024); } while (0)
#define PG8_MMA(ai, bj, At, Bt) do { __builtin_amdgcn_s_setprio(1); _Pragma("unroll") for (int m = 0; m < 4; ++m) _Pragma("unroll") for (int n = 0; n < 2; ++n) _Pragma("unroll") for (int k = 0; k < 2; ++k) \
        acc[ai][bj][m][n] = __builtin_amdgcn_mfma_f32_16x16x32_bf16(Bt[n][k], At[m][k], acc[ai][bj][m][n], 0, 0, 0); __builtin_amdgcn_s_setprio(0); } while (0)
#define PG8_WAIT_V(n) asm volatile("s_waitcnt vmcnt(" #n ")" ::: "memory")
#define PG8_WAIT_L(n) asm volatile("s_waitcnt lgkmcnt(" #n ")" ::: "memory")
#define PG8_BAR __builtin_amdgcn_s_barrier()
#define PG8_SCHED __builtin_amdgcn_sched_barrier(0)
    Unit cur, nxt; int ui = 0;
    if (!S.next(0, cur)) return;
    f32x4 acc[2][2][4][2];
#pragma unroll
    for (int a = 0; a < 2; ++a)
#pragma unroll
        for (int b = 0; b < 2; ++b)
#pragma unroll
            for (int m = 0; m < 4; ++m)
#pragma unroll
                for (int n = 0; n < 2; ++n) acc[a][b][m][n] = (f32x4){0.f, 0.f, 0.f, 0.f};
    bf16x8 At[4][2], B0[2][2], B1[2][2];
    const char* cA = (const char*)g.A + (size_t)cur.pm * tstep; const char* cB = (const char*)g.Bt + (size_t)cur.pn * tstep;
    PG8_STAGE(PG8_SB(0, 0), cB, voffB); PG8_STAGE(PG8_SA(0, 0), cA, voffA); PG8_STAGE(PG8_SB(0, 1), cB + hstep, voffB); PG8_STAGE(PG8_SA(0, 1), cA + hstep, voffA);
    if (wr == 1) PG8_BAR;
    PG8_WAIT_V(4); PG8_BAR;
    PG8_STAGE(PG8_SB(1, 0), cB + kstep, voffB); PG8_STAGE(PG8_SA(1, 0), cA + kstep, voffA); PG8_STAGE(PG8_SB(1, 1), cB + hstep + kstep, voffB);
    PG8_WAIT_V(6); PG8_BAR;
    for (;;) {
        const bool has_next = S.next(ui + 1, nxt);
        const char* nA = has_next ? (const char*)g.A + (size_t)nxt.pm * tstep : cA; const char* nB = has_next ? (const char*)g.Bt + (size_t)nxt.pn * tstep : cB;
        for (int t = 0; t < nt; t += 2) {
            const bool last = (t == nt - 2);
            const char* a1 = cA + (size_t)(t + 1) * kstep;
            const char* a2 = last ? nA : cA + (size_t)(t + 2) * kstep; const char* b2 = last ? nB : cB + (size_t)(t + 2) * kstep;
            const char* a3 = a2 + kstep; const char* b3 = b2 + kstep;
            PG8_LDB(B0, 0, 0); PG8_SCHED; PG8_LDA(At, 0, 0); PG8_STAGE(PG8_SA(1, 1), a1 + hstep, voffA);
            PG8_WAIT_L(8); PG8_BAR; PG8_WAIT_L(0); PG8_MMA(0, 0, At, B0); PG8_BAR; PG8_SCHED;
            PG8_LDB(B1, 0, 1); PG8_STAGE(PG8_SB(0, 0), b2, voffB);
            PG8_BAR; PG8_WAIT_L(0); PG8_MMA(0, 1, At, B1); PG8_BAR;
            PG8_LDA(At, 0, 1); PG8_STAGE(PG8_SA(0, 0), a2, voffA);
            PG8_BAR; PG8_WAIT_L(0); PG8_MMA(1, 0, At, B0); PG8_BAR; PG8_SCHED;
            PG8_STAGE(PG8_SB(0, 1), b2 + hstep, voffB);
            PG8_WAIT_V(6); PG8_BAR; PG8_MMA(1, 1, At, B1); PG8_BAR;
            PG8_LDB(B0, 1, 0); PG8_SCHED; PG8_LDA(At, 1, 0); PG8_STAGE(PG8_SA(0, 1), a2 + hstep, voffA);
            PG8_WAIT_L(8); PG8_BAR; PG8_WAIT_L(0); PG8_MMA(0, 0, At, B0); PG8_BAR; PG8_SCHED;
            PG8_LDB(B1, 1, 1); PG8_STAGE(PG8_SB(1, 0), b3, voffB);
            PG8_BAR; PG8_WAIT_L(0); PG8_MMA(0, 1, At, B1); PG8_BAR;
            PG8_LDA(At, 1, 1); PG8_STAGE(PG8_SA(1, 0), a3, voffA);
            PG8_BAR; PG8_WAIT_L(0); PG8_MMA(1, 0, At, B0); PG8_BAR; PG8_SCHED;
            PG8_STAGE(PG8_SB(1, 1), b3 + hstep, voffB);
            PG8_WAIT_V(6); PG8_BAR; PG8_MMA(1, 1, At, B1); PG8_BAR;
        }
        E(acc, cur, wr, wc, fr, fq);
        if (!has_next) break;
#pragma unroll
        for (int a = 0; a < 2; ++a)
#pragma unroll
            for (int b = 0; b < 2; ++b)
#pragma unroll
                for (int m = 0; m < 4; ++m)
#pragma unroll
                    for (int n = 0; n < 2; ++n) acc[a][b][m][n] = (f32x4){0.f, 0.f, 0.f, 0.f};
        cur = nxt; cA = nA; cB = nB; ++ui;
    }
    PG8_WAIT_V(0);
    if (wr == 0) PG8_BAR;
    PG8_BAR;
#undef PG8_SA
#undef PG8_SB
#undef PG8_STAGE
#undef PG8_LDA
#undef PG8_LDB
#undef PG8_MMA
#undef PG8_WAIT_V
#undef PG8_WAIT_L
#undef PG8_BAR
#undef PG8_SCHED
}
}

enum { M_SPLIT = 0, M_VLW, M_LA, M_L2, M_G, M_PGATE, M_AGATE, M_OUT, M_PLE };
struct EpiArgs {
    int mode, pad_;
    bf16_t* o0; bf16_t* o1; bf16_t* o2; const bf16_t* i0;
    const float* f0; const float* f1; const float* f2;
    float* hout; const float* hin; const float* lse;
    float* ssq_out; const float* ssq_in; bf16_t* hb;
};

__device__ __forceinline__ void store8(bf16_t* p, const f32x4& v0, const f32x4& v1) {
    u32x4 o; o[0] = cvt_pk_bf16(v0[0], v0[1]); o[1] = cvt_pk_bf16(v0[2], v0[3]); o[2] = cvt_pk_bf16(v1[0], v1[1]); o[3] = cvt_pk_bf16(v1[2], v1[3]);
    *(u32x4*)p = o;
}
__device__ __forceinline__ void load8(const bf16_t* p, f32x4& v0, f32x4& v1) {
    const u32x4 o = *(const u32x4*)p;
    v0[0] = bf_lo(o[0]); v0[1] = bf_hi(o[0]); v0[2] = bf_lo(o[1]); v0[3] = bf_hi(o[1]);
    v1[0] = bf_lo(o[2]); v1[1] = bf_hi(o[2]); v1[2] = bf_lo(o[3]); v1[3] = bf_hi(o[3]);
}

template <bool PERM_> struct Epi {
    static constexpr bool PERM = PERM_;
    EpiArgs a;
    struct Pre { float rs; float ls[6]; u32x4 q[6]; };
    template <int MODE> __device__ __forceinline__ Pre loadpre(int row, int pn, int colt) const {
        Pre p; p.rs = 1.0f;
        if constexpr (MODE == M_SPLIT || MODE == M_PGATE || MODE == M_AGATE) p.rs = a.ssq_in[row];
        if constexpr (MODE == M_G) {
#pragma unroll
            for (int bj = 0; bj < 2; ++bj) p.q[bj] = *(const u32x4*)(a.o0 + (size_t)row * DM + pn * 256 + bj * 128 + colt);
        }
        if constexpr (MODE == M_AGATE) {
#pragma unroll
            for (int bj = 0; bj < 2; ++bj) {
                const int c = pn * 256 + bj * 128 + colt, head = c >> 7;
#pragma unroll
                for (int g = 0; g < 3; ++g) {
                    p.ls[bj * 3 + g] = a.lse[((size_t)g * T_TOK + row) * 8 + head];
                    p.q[bj * 3 + g] = *(const u32x4*)(a.o0 + (size_t)g * ARR_E + (size_t)row * DM + c);
                }
            }
        }
        return p;
    }
    __device__ __forceinline__ static void unpack8(const u32x4& o, f32x4& v0, f32x4& v1) {
        v0[0] = bf_lo(o[0]); v0[1] = bf_hi(o[0]); v0[2] = bf_lo(o[1]); v0[3] = bf_hi(o[1]);
        v1[0] = bf_lo(o[2]); v1[1] = bf_hi(o[2]); v1[2] = bf_lo(o[3]); v1[3] = bf_hi(o[3]);
    }
    template <int MODE> __device__ __forceinline__ void epi8(int row, int pn, int col0, int bj, f32x4 v0, f32x4 v1, const Pre& pre) const {
        if constexpr (MODE == M_SPLIT) {
            bf16_t* dst = a.o0 + (size_t)(pn >> 2) * ARR_E + (size_t)row * DM + (pn & 3) * 256 + col0;
            store8(dst, v0, v1);
        } else if constexpr (MODE == M_VLW) {
            if (pn < 4) { store8(a.o0 + (size_t)row * DM + pn * 256 + col0, v0, v1); }
            else if (pn == 4) { if (col0 < 32) store8(a.o1 + (size_t)row * LP + 128 + col0, v0, v1); }
            else if (pn == 5) { if (col0 < 64) {
#pragma unroll
                    for (int i = 0; i < 4; ++i) { v0[i] = tanhf(v0[i]); v1[i] = tanhf(v1[i]); }
                    store8(a.o1 + (size_t)row * LP + col0, v0, v1); } }
            else { if (col0 < 64) store8(a.o1 + (size_t)row * LP + 64 + col0, v0, v1); }
        } else if constexpr (MODE == M_G) {
            bf16_t* dst = a.o0 + (size_t)row * DM + pn * 256 + col0;
            f32x4 x0, x1; unpack8(pre.q[bj], x0, x1);
#pragma unroll
            for (int i = 0; i < 4; ++i) { v0[i] = x0[i] * siluf_(v0[i]); v1[i] = x1[i] * siluf_(v1[i]); }
            store8(dst, v0, v1);
        } else if constexpr (MODE == M_PGATE) {
#pragma unroll
            for (int i = 0; i < 4; ++i) { v0[i] = sigmoidf_(v0[i]); v1[i] = sigmoidf_(v1[i]); }
            store8(a.o0 + (size_t)row * DM + pn * 256 + col0, v0, v1);
        } else if constexpr (MODE == M_AGATE) {
            const int c = pn * 256 + col0;
            const float l0 = pre.ls[bj * 3], l1 = pre.ls[bj * 3 + 1], l2 = pre.ls[bj * 3 + 2];
            const float mx = fmaxf(l0, fmaxf(l1, l2));
            float w0 = __builtin_amdgcn_exp2f(1.4426950408889634f * (l0 - mx)), w1 = __builtin_amdgcn_exp2f(1.4426950408889634f * (l1 - mx)), w2 = __builtin_amdgcn_exp2f(1.4426950408889634f * (l2 - mx));
            const float inv = __builtin_amdgcn_rcpf(w0 + w1 + w2); w0 *= inv; w1 *= inv; w2 *= inv;
            bf16_t* p0 = a.o0 + (size_t)row * DM + c;
            f32x4 x0, x1, y0, y1, z0, z1; unpack8(pre.q[bj * 3], x0, x1); unpack8(pre.q[bj * 3 + 1], y0, y1); unpack8(pre.q[bj * 3 + 2], z0, z1);
#pragma unroll
            for (int i = 0; i < 4; ++i) {
                v0[i] = (w0 * x0[i] + w1 * y0[i] + w2 * z0[i]) * siluf_(v0[i]);
                v1[i] = (w0 * x1[i] + w1 * y1[i] + w2 * z1[i]) * siluf_(v1[i]); }
            store8(p0, v0, v1);
        }
    }
    template <int MODE, int NB> __device__ __forceinline__ void runp(const f32x4 (&acc)[2][2][4][2], const pg8::Unit& u, int rowbase, int wc, int fq) const {
        const int colt = wc * 32 + 8 * fq;
#pragma unroll
        for (int b0 = 0; b0 < 8; b0 += NB) {
            Pre pre[NB];
#pragma unroll
            for (int j = 0; j < NB; ++j) pre[j] = loadpre<MODE>(rowbase + ((b0 + j) >> 2) * 128 + ((b0 + j) & 3) * 16, u.pn, colt);
#pragma unroll
            for (int j = 0; j < NB; ++j) {
                const int ai = (b0 + j) >> 2, m = (b0 + j) & 3;
                const int row = rowbase + ai * 128 + m * 16;
                float rs = 1.0f;
                if constexpr (MODE == M_SPLIT || MODE == M_PGATE || MODE == M_AGATE) rs = rsqrtf(pre[j].rs * (1.0f / 1024.0f) + 1e-6f);
#pragma unroll
                for (int bj = 0; bj < 2; ++bj) epi8<MODE>(row, u.pn, bj * 128 + colt, bj, acc[ai][bj][m][0] * rs, acc[ai][bj][m][1] * rs, pre[j]);
            }
        }
    }
    struct PreF { f32x4 hv[4]; u32x4 gg[2]; };
    template <int MODE> __device__ __forceinline__ PreF loadpref(int row, int pn, int colt) const {
        PreF p;
#pragma unroll
        for (int bj = 0; bj < 2; ++bj) {
            const size_t off = (size_t)row * DM + pn * 256 + bj * 128 + colt;
            p.hv[bj * 2] = *(const f32x4*)(a.hin + off); p.hv[bj * 2 + 1] = *(const f32x4*)(a.hin + off + 4);
            if constexpr (MODE == M_PLE) p.gg[bj] = *(const u32x4*)(a.i0 + off);
        }
        return p;
    }
    template <int MODE, int NB> __device__ __forceinline__ void runf(const f32x4 (&acc)[2][2][4][2], const pg8::Unit& u, int rowbase, int wc, int fq) const {
        const int colt = wc * 32 + 8 * fq;
#pragma unroll
        for (int b0 = 0; b0 < 8; b0 += NB) {
            PreF pre[NB];
#pragma unroll
            for (int j = 0; j < NB; ++j) pre[j] = loadpref<MODE>(rowbase + ((b0 + j) >> 2) * 128 + ((b0 + j) & 3) * 16, u.pn, colt);
#pragma unroll
            for (int j = 0; j < NB; ++j) {
                const int ai = (b0 + j) >> 2, m = (b0 + j) & 3;
                const int row = rowbase + ai * 128 + m * 16;
                float ss = 0.f;
#pragma unroll
                for (int bj = 0; bj < 2; ++bj) {
                    const size_t off = (size_t)row * DM + u.pn * 256 + bj * 128 + colt;
                    const f32x4 v0 = acc[ai][bj][m][0], v1 = acc[ai][bj][m][1];
                    f32x4 o0, o1;
                    if constexpr (MODE == M_OUT) {
                        o0 = pre[j].hv[bj * 2] + v0; o1 = pre[j].hv[bj * 2 + 1] + v1;
                    } else {
                        f32x4 g0, g1; unpack8(pre[j].gg[bj], g0, g1);
                        o0 = pre[j].hv[bj * 2] + v0 * g0; o1 = pre[j].hv[bj * 2 + 1] + v1 * g1;
                    }
                    *(f32x4*)(a.hout + off) = o0; *(f32x4*)(a.hout + off + 4) = o1;
                    if (a.hb) store8(a.hb + off, o0, o1);
                    ss += (o0[0] * o0[0] + o0[1] * o0[1]) + (o0[2] * o0[2] + o0[3] * o0[3]) + (o1[0] * o1[0] + o1[1] * o1[1]) + (o1[2] * o1[2] + o1[3] * o1[3]);
                }
                if (a.ssq_out) { ss += __shfl_xor(ss, 16, 64); ss += __shfl_xor(ss, 32, 64);
                    if (fq == 0) atomicAdd(a.ssq_out + row, ss); }
            }
        }
    }
    __device__ __forceinline__ void operator()(const f32x4 (&acc)[2][2][4][2], const pg8::Unit& u, int wr, int wc, int fr, int fq) const {
        const int rowbase = (u.pm & 127) * 256 + wr * 64 + fr;
        if constexpr (PERM_) {
            switch (a.mode) {
            case M_SPLIT: runp<M_SPLIT, 8>(acc, u, rowbase, wc, fq); break;
            case M_VLW: runp<M_VLW, 8>(acc, u, rowbase, wc, fq); break;
            case M_G: runp<M_G, 4>(acc, u, rowbase, wc, fq); break;
            case M_PGATE: runp<M_PGATE, 8>(acc, u, rowbase, wc, fq); break;
            case M_OUT: runf<M_OUT, 2>(acc, u, rowbase, wc, fq); break;
            case M_PLE: runf<M_PLE, 2>(acc, u, rowbase, wc, fq); break;
            default: runp<M_AGATE, 1>(acc, u, rowbase, wc, fq); break;
            }
        }
    }
};

struct CJob { const float* src; bf16_t* dst; int K, N, nrows, ldd, koff; const float* ksc; };
__device__ __forceinline__ void conv_job(const CJob& j, int& cum, float* tile, int tid_, int bid_) {
    const int lane = tid_ & 63, w = tid_ >> 6, GW = gridDim.x * 8;
    float* tl = tile + w * (64 * 65);
    const int tn = j.nrows >> 6, tk = j.ldd >> 6, ntiles = tn * tk;
    const int start = ((bid_ * 8 + w) - (cum % GW) + GW) % GW;
    for (int t = start; t < ntiles; t += GW) {
        const int n0 = (t / tk) * 64, k0 = (t % tk) * 64;
        f32x4 v[16];
#pragma unroll
        for (int i = 0; i < 16; ++i) {
            const int idx = lane + 64 * i, kl = idx >> 4, n4 = (idx & 15) * 4;
            const int k = k0 + kl - j.koff, n = n0 + n4;
            v[i] = (f32x4){0.f, 0.f, 0.f, 0.f};
            if (k >= 0 && k < j.K && n < j.N) { v[i] = *(const f32x4*)(j.src + (size_t)k * j.N + n); if (j.ksc) v[i] = v[i] * j.ksc[k]; }
        }
#pragma unroll
        for (int i = 0; i < 16; ++i) {
            const int idx = lane + 64 * i, kl = idx >> 4, n4 = (idx & 15) * 4;
#pragma unroll
            for (int e = 0; e < 4; ++e) tl[kl * 65 + n4 + e] = v[i][e];
        }
        __builtin_amdgcn_wave_barrier();
#pragma unroll
        for (int jj = 0; jj < 8; ++jj) {
            const int idx = lane + 64 * jj, nl = idx >> 3, k8 = (idx & 7) * 8;
            float x[8];
#pragma unroll
            for (int e = 0; e < 8; ++e) x[e] = tl[(k8 + e) * 65 + nl];
            u32x4 o; o[0] = cvt_pk_bf16(x[0], x[1]); o[1] = cvt_pk_bf16(x[2], x[3]); o[2] = cvt_pk_bf16(x[4], x[5]); o[3] = cvt_pk_bf16(x[6], x[7]);
            *(u32x4*)(j.dst + (size_t)(n0 + nl) * j.ldd + k0 + k8) = o;
        }
        __builtin_amdgcn_wave_barrier();
    }
    cum += ntiles;
}
__device__ __forceinline__ void convert_phase(PP P, float* tile, int tid_, int bid_) {
    bf16_t* W = (bf16_t*)(P->ws + WS_W);
    int cum = 0;
    { float* ssq = (float*)(P->ws + WS_SSQ); for (int i = bid_ * 512 + tid_; i < 9 * T_TOK; i += gridDim.x * 512) ssq[i] = (i < 8 * T_TOK) ? 0.f : 1023.999f; }
    for (int l = 0; l < 2; ++l) {
        bf16_t* base = W + l * RW_STRIDE;
        const float* rkvg = P->in[4] + (size_t)l * 4 * 1048576;
        CJob j;
        j = {rkvg, base + RW_WRK, 1024, 1024, 1024, 1024, 0, nullptr}; conv_job(j, cum, tile, tid_, bid_);
        j = {rkvg + 1048576, base + RW_WRK + 1048576, 1024, 1024, 1024, 1024, 0, nullptr}; conv_job(j, cum, tile, tid_, bid_);
        j = {rkvg + 2 * 1048576, base + RW_WVW, 1024, 1024, 1024, 1024, 0, nullptr}; conv_job(j, cum, tile, tid_, bid_);
        j = {P->in[12], base + RW_WVW + 1048576, 1024, l == 0 ? 0 : 32, 256, 1024, 0, nullptr}; conv_job(j, cum, tile, tid_, bid_);
        j = {P->in[6] + (size_t)l * 65536, base + RW_WVW + 1048576 + 262144, 1024, 64, 256, 1024, 0, nullptr}; conv_job(j, cum, tile, tid_, bid_);
        j = {P->in[9] + (size_t)l * 65536, base + RW_WA1, 1024, 64, 256, 1024, 0, nullptr}; conv_job(j, cum, tile, tid_, bid_);
        j = {P->in[7] + (size_t)l * 65536, base + RW_W2C, 64, 1024, 1024, 256, 0, nullptr}; conv_job(j, cum, tile, tid_, bid_);
        j = {P->in[10] + (size_t)l * 65536, base + RW_W2C + 262144, 64, 1024, 1024, 256, 64, nullptr}; conv_job(j, cum, tile, tid_, bid_);
        j = {P->in[13], base + RW_W2C + 524288, 32, l == 0 ? 0 : 1024, 1024, 256, 128, nullptr}; conv_job(j, cum, tile, tid_, bid_);
        j = {rkvg + 3 * 1048576, base + RW_WG, 1024, 1024, 1024, 1024, 0, nullptr}; conv_job(j, cum, tile, tid_, bid_);
        j = {P->in[19] + (size_t)l * 1048576, base + RW_WO, 1024, 1024, 1024, 1024, 0, nullptr}; conv_job(j, cum, tile, tid_, bid_);
    }
    for (int i = 0; i < 4; ++i) {
        bf16_t* base = W + PLE_BASE + i * PLE_STRIDE;
        CJob j;
        j = {P->in[27] + (size_t)i * 1048576, base, 1024, 1024, 1024, 1024, 0, P->in[26] + i * 1024}; conv_job(j, cum, tile, tid_, bid_);
        j = {P->in[25] + (size_t)i * 262144, base + PLE_WP, 256, 1024, 1024, 256, 0, nullptr}; conv_job(j, cum, tile, tid_, bid_);
    }
    { CJob j = {P->in[21], W + KV_BASE, 1024, 2048, 2048, 1024, 0, nullptr}; conv_job(j, cum, tile, tid_, bid_); }
    for (int q = 0; q < 2; ++q) {
        bf16_t* base = W + ATT_BASE + q * ATT_STRIDE;
        CJob j;
        j = {P->in[23] + (size_t)q * 4194304, base, 1024, 4096, 4096, 1024, 0, P->in[22] + q * 1024}; conv_job(j, cum, tile, tid_, bid_);
        j = {P->in[24] + (size_t)q * 1048576, base + ATT_WO, 1024, 1024, 1024, 1024, 0, nullptr}; conv_job(j, cum, tile, tid_, bid_);
    }
}

__device__ __forceinline__ void pconv(PP P, int layer, bool zeroL, int tid_, int bid_) {
    const float* src = P->in[1] + (size_t)layer * T_TOK * 256;
    bf16_t* dst = (bf16_t*)(P->ws + WS_P);
    const size_t n8 = (size_t)T_TOK * 256 / 8, stride = (size_t)gridDim.x * 512;
    if (layer >= 0) for (size_t i = (size_t)bid_ * 512 + tid_; i < n8; i += 4 * stride) {
        f32x4 av[4], bv[4];
#pragma unroll
        for (int u = 0; u < 4; ++u) { const size_t ii = i + u * stride; if (ii < n8) { av[u] = *(const f32x4*)(src + ii * 8); bv[u] = *(const f32x4*)(src + ii * 8 + 4); } }
#pragma unroll
        for (int u = 0; u < 4; ++u) { const size_t ii = i + u * stride; if (ii < n8) store8(dst + ii * 8, av[u], bv[u]); }
    }
    if (zeroL) {
        bf16_t* L = (bf16_t*)(P->ws + WS_L);
        const size_t nz = (size_t)T_TOK * 16;
        for (size_t i = (size_t)bid_ * 512 + tid_; i < nz; i += stride) {
            const size_t row = i >> 4, cc = i & 15;
            *(u32x4*)(L + row * 256 + 128 + cc * 8) = (u32x4){0u, 0u, 0u, 0u};
        }
    }
}

__device__ __forceinline__ void load_row(const float* p, int lane, f32x4 (&r)[4]) {
#pragma unroll
    for (int i = 0; i < 4; ++i) r[i] = *(const f32x4*)(p + lane * 4 + 256 * i);
}
__device__ __forceinline__ float row_rstd(const f32x4 (&r)[4]) {
    float ss = 0.f;
#pragma unroll
    for (int i = 0; i < 4; ++i) ss += r[i][0] * r[i][0] + r[i][1] * r[i][1] + r[i][2] * r[i][2] + r[i][3] * r[i][3];
    ss = wave_sum(ss);
    return rsqrtf(ss * (1.0f / 1024.0f) + 1e-6f);
}
__device__ __forceinline__ void prep_shift(const float* hin, const float* g, const float* mu0, const float* mu1, const float* mu2, bf16_t* X0, bf16_t* X1, bf16_t* X2, int tid_, int bid_,
                                           const bf16_t* Yr, const bf16_t* Ad, const float* gng, const float* gnb, bf16_t* Yo) {
    const int lane = tid_ & 63, gw = bid_ * 8 + (tid_ >> 6);
    const int per = T_TOK / (gridDim.x * 8);
    f32x4 gv[4], m0[4], m1[4], m2[4], prev[4], row[4];
    load_row(g, lane, gv); load_row(mu0, lane, m0);
    if (X1) load_row(mu1, lane, m1);
    if (X2) load_row(mu2, lane, m2);
    const int t0 = gw * per;
    if ((t0 & (SEQ - 1)) == 0) {
#pragma unroll
        for (int i = 0; i < 4; ++i) prev[i] = (f32x4){0.f, 0.f, 0.f, 0.f};
    } else {
        load_row(hin + (size_t)(t0 - 1) * DM, lane, row);
        const float rs = row_rstd(row);
#pragma unroll
        for (int i = 0; i < 4; ++i) prev[i] = row[i] * rs * gv[i];
    }
    f32x4 rown[4];
    load_row(hin + (size_t)t0 * DM, lane, rown);
    f32x4 gng4[4], gnb4[4]; u32x2 yqn[4], aqn[4];
    if (Yo) {
        load_row(gng, lane, gng4); load_row(gnb, lane, gnb4);
#pragma unroll
        for (int i = 0; i < 4; ++i) { const size_t off = (size_t)t0 * DM + lane * 4 + 256 * i; yqn[i] = *(const u32x2*)(Yr + off); aqn[i] = *(const u32x2*)(Ad + off); }
    }
    for (int k = 0; k < per; ++k) {
        const int t = t0 + k;
#pragma unroll
        for (int i = 0; i < 4; ++i) row[i] = rown[i];
        load_row(hin + (size_t)(k + 1 < per ? t + 1 : t) * DM, lane, rown);
        u32x2 yqc[4], aqc[4];
        if (Yo) {
#pragma unroll
            for (int i = 0; i < 4; ++i) { yqc[i] = yqn[i]; aqc[i] = aqn[i];
                const size_t off = (size_t)(k + 1 < per ? t + 1 : t) * DM + lane * 4 + 256 * i; yqn[i] = *(const u32x2*)(Yr + off); aqn[i] = *(const u32x2*)(Ad + off); }
        }
        const float rs = row_rstd(row);
#pragma unroll
        for (int i = 0; i < 4; ++i) {
            const f32x4 xn = row[i] * rs * gv[i];
            const f32x4 xx = prev[i] - xn;
            const f32x4 a = xn + xx * m0[i];
            u32x2 o; o[0] = cvt_pk_bf16(a[0], a[1]); o[1] = cvt_pk_bf16(a[2], a[3]);
            *(u32x2*)(X0 + (size_t)t * DM + lane * 4 + 256 * i) = o;
            if (X1) {
                const f32x4 b = xn + xx * m1[i];
                u32x2 o2; o2[0] = cvt_pk_bf16(b[0], b[1]); o2[1] = cvt_pk_bf16(b[2], b[3]);
                *(u32x2*)(X1 + (size_t)t * DM + lane * 4 + 256 * i) = o2;
            }
            if (X2) {
                const f32x4 b = xn + xx * m2[i];
                u32x2 o2; o2[0] = cvt_pk_bf16(b[0], b[1]); o2[1] = cvt_pk_bf16(b[2], b[3]);
                *(u32x2*)(X2 + (size_t)t * DM + lane * 4 + 256 * i) = o2;
            }
            prev[i] = xn;
        }
        if (Yo) {
#pragma unroll
            for (int i = 0; i < 4; ++i) {
                const size_t off = (size_t)t * DM + lane * 4 + 256 * i;
                const u32x2 yq = yqc[i], aq = aqc[i];
                const f32x4 y4 = {bf_lo(yq[0]), bf_hi(yq[0]), bf_lo(yq[1]), bf_hi(yq[1])};
                const f32x4 a4 = {bf_lo(aq[0]), bf_hi(aq[0]), bf_lo(aq[1]), bf_hi(aq[1])};
                float sm = (y4[0] + y4[1]) + (y4[2] + y4[3]);
                sm = sum16d(sm);
                const float mean = sm * (1.0f / 64.0f);
                const f32x4 yc = y4 - mean;
                float vs = yc[0] * yc[0] + yc[1] * yc[1] + yc[2] * yc[2] + yc[3] * yc[3];
                vs = sum16d(vs);
                const float r2 = rsqrtf(vs * (1.0f / 64.0f) + 64e-5f);
                const f32x4 ov = yc * r2 * gng4[i] + gnb4[i] + a4;
                u32x2 o; o[0] = cvt_pk_bf16(ov[0], ov[1]); o[1] = cvt_pk_bf16(ov[2], ov[3]);
                *(u32x2*)(Yo + off) = o;
            }
        }
    }
}
__device__ __forceinline__ void prep_plain(const float* hin, const float* g, bf16_t* X0, int tid_, int bid_) {
    const int lane = tid_ & 63, gw = bid_ * 8 + (tid_ >> 6);
    const int per = T_TOK / (gridDim.x * 8);
    f32x4 gv[4], row[4];
    load_row(g, lane, gv);
    for (int k = 0; k < per; ++k) {
        const int t = gw * per + k;
        load_row(hin + (size_t)t * DM, lane, row);
        const float rs = row_rstd(row);
#pragma unroll
        for (int i = 0; i < 4; ++i) {
            const f32x4 a = row[i] * rs * gv[i];
            u32x2 o; o[0] = cvt_pk_bf16(a[0], a[1]); o[1] = cvt_pk_bf16(a[2], a[3]);
            *(u32x2*)(X0 + (size_t)t * DM + lane * 4 + 256 * i) = o;
        }
    }
}
__device__ __forceinline__ void final_norm(float* h, const float* g, const float* ssq, int tid_, int bid_) {
    const int lane = tid_ & 63, gw = bid_ * 8 + (tid_ >> 6);
    const int per = T_TOK / (gridDim.x * 8);
    f32x4 gv[4], r0[4], r1[4], r2[4];
    load_row(g, lane, gv);
    const int t0 = gw * per;
    load_row(h + (size_t)t0 * DM, lane, r0); float s0 = ssq[t0];
    load_row(h + (size_t)(t0 + 1) * DM, lane, r1); float s1 = ssq[t0 + 1];
    for (int k = 0; k < per; ++k) {
        const int t = t0 + k;
        const int tn = (k + 2 < per) ? t + 2 : t;
        load_row(h + (size_t)tn * DM, lane, r2); const float s2 = ssq[tn];
        const float rs = rsqrtf(s0 * (1.0f / 1024.0f) + 1e-6f);
#pragma unroll
        for (int i = 0; i < 4; ++i) *(f32x4*)(h + (size_t)t * DM + lane * 4 + 256 * i) = r0[i] * rs * gv[i];
#pragma unroll
        for (int i = 0; i < 4; ++i) { r0[i] = r1[i]; r1[i] = r2[i]; }
        s0 = s1; s1 = s2;
    }
}

constexpr int TC = 32;
typedef float f32x2 __attribute__((ext_vector_type(2)));
struct StepOps { f32x4 k0, k1, k2, k3, wa, wb, ba, bb, xa, xb; };
constexpr int VTP = TC + 4;
constexpr int SB_KR = 0, SB_WW = TC * 128, SB_BN = SB_WW + TC * 64, SB_KX = SB_BN + TC * 64, SB_VV = SB_KX + TC * 64, SB_ADD = SB_VV + 32 * VTP, SB_SC = SB_ADD + TC * 32, SB_SIZE = SB_SC + 2 * TC;
__device__ __forceinline__ void scan_phase(PP P, int l, float* L, int tid_, int bid_, const bf16_t* Lo) {
    float* s_y = L + 2 * SB_SIZE;
    unsigned char* s_w2 = (unsigned char*)(s_y + 2 * TC * 32);
    const int pair = bid_ >> 1, half = bid_ & 1;
    const int b = pair >> 4, h = pair & 15;
    const int tid = tid_, lane = tid & 63, w = tid >> 6, l15 = lane & 15, quad = lane >> 4;
    const bool prod = (w >= 4);
    const int ptid = tid & 255;
    const int tt = ptid >> 4, cgp = ptid & 15, ch = h * 64 + 4 * cgp;
    const bool own = (cgp >> 3) == half;
    bf16_t* arr = (bf16_t*)(P->ws + WS_ARR);
    const bf16_t* R = arr + 2 * ARR_E; const bf16_t* Kp = arr + 3 * ARR_E;
    const bf16_t* V = arr + (size_t)(l == 0 ? 4 : 5) * ARR_E; const bf16_t* Vf = arr + 4 * ARR_E;
    bf16_t* Yr = arr + 5 * ARR_E; bf16_t* Ad = arr + ARR_E;
    const f32x4 pkk = *(const f32x4*)(P->in[14] + l * 1024 + ch), pka = *(const f32x4*)(P->in[15] + l * 1024 + ch), prk = *(const f32x4*)(P->in[16] + l * 1024 + ch);
    const size_t rowbase = (size_t)b * SEQ;
    const int mt = w & 1, ntb = 2 * ((w >> 1) & 1);
    const bf16_t* W2 = (const bf16_t*)(P->ws + WS_W) + l * RW_STRIDE + RW_W2C;
    {
        const int rr = tid >> 3, pc = tid & 7;
        *(u32x4*)(s_w2 + rr * 144 + pc * 16) = *(const u32x4*)(W2 + (size_t)(h * 64 + rr) * 256 + pc * 8);
        *(u32x4*)(s_w2 + 9216 + rr * 144 + pc * 16) = *(const u32x4*)(W2 + (size_t)(1024 + h * 64 + rr) * 256 + 64 + pc * 8);
        if (tid < 256) { const int r2 = tid >> 2, p2 = tid & 3; *(u32x4*)(s_w2 + 18432 + r2 * 80 + p2 * 16) = *(const u32x4*)(W2 + (size_t)(2048 + h * 64 + r2) * 256 + 128 + p2 * 8); }
    }
    float w0c[2], a0c[2], v0c[2];
#pragma unroll
    for (int n2 = 0; n2 < 2; ++n2) {
        const int chn = h * 64 + 16 * (ntb + n2) + l15;
        w0c[n2] = P->in[5][l * 1024 + chn]; a0c[n2] = P->in[8][l * 1024 + chn]; v0c[n2] = P->in[11][chn];
    }
    u32x2 qr[2], qk[2], qv[2], qf[2];
    bf16x8 lw[2], la[2], lv;
    auto issue = [&](int c) {
#pragma unroll
        for (int u = 0; u < 2; ++u) {
            const size_t off = (rowbase + (size_t)c * TC + tt + 16 * u) * DM + ch;
            qr[u] = *(const u32x2*)(R + off); qk[u] = *(const u32x2*)(Kp + off);
            qv[u] = (u32x2){0u, 0u}; qf[u] = (u32x2){0u, 0u};
            if (own) { qv[u] = *(const u32x2*)(V + off); if (l) qf[u] = *(const u32x2*)(Vf + off); }
        }
        const bf16_t* lrow = Lo + (rowbase + (size_t)c * TC + 16 * mt + l15) * LP;
        lw[0] = *(const bf16x8*)(lrow + quad * 8); lw[1] = *(const bf16x8*)(lrow + 32 + quad * 8);
        la[0] = *(const bf16x8*)(lrow + 64 + quad * 8); la[1] = *(const bf16x8*)(lrow + 96 + quad * 8);
        lv = *(const bf16x8*)(lrow + 128 + quad * 8);
    };
    auto lora2 = [&](float* sb) {
#pragma unroll
        for (int n2 = 0; n2 < 2; ++n2) {
            f32x4 aw = {0.f, 0.f, 0.f, 0.f}, aa = {0.f, 0.f, 0.f, 0.f}, av = {0.f, 0.f, 0.f, 0.f};
            const int chl = 16 * (ntb + n2) + l15;
            const bf16x8 bw0 = *(const bf16x8*)(s_w2 + chl * 144 + quad * 16), bw1 = *(const bf16x8*)(s_w2 + chl * 144 + 64 + quad * 16);
            const bf16x8 ba0 = *(const bf16x8*)(s_w2 + 9216 + chl * 144 + quad * 16), ba1 = *(const bf16x8*)(s_w2 + 9216 + chl * 144 + 64 + quad * 16);
            aw = __builtin_amdgcn_mfma_f32_16x16x32_bf16(lw[0], bw0, aw, 0, 0, 0);
            aw = __builtin_amdgcn_mfma_f32_16x16x32_bf16(lw[1], bw1, aw, 0, 0, 0);
            aa = __builtin_amdgcn_mfma_f32_16x16x32_bf16(la[0], ba0, aa, 0, 0, 0);
            aa = __builtin_amdgcn_mfma_f32_16x16x32_bf16(la[1], ba1, aa, 0, 0, 0);
            if (l) { const bf16x8 bv0 = *(const bf16x8*)(s_w2 + 18432 + chl * 80 + quad * 16); av = __builtin_amdgcn_mfma_f32_16x16x32_bf16(lv, bv0, av, 0, 0, 0); }
#pragma unroll
            for (int e = 0; e < 4; ++e) {
                const int o = (16 * mt + 4 * quad + e) * 64 + chl;
                sb[SB_WW + o] = 0.60653066f * sigmoidf_(w0c[n2] + aw[e]);
                sb[SB_BN + o] = sigmoidf_(a0c[n2] + aa[e]);
                if (l) sb[SB_KX + o] = sigmoidf_(v0c[n2] + av[e]);
            }
        }
    };
    auto prep = [&](float* sb) {
#pragma unroll
        for (int u = 0; u < 2; ++u) {
            const int tk = tt + 16 * u;
            const int o = tk * 64 + 4 * cgp;
            f32x4 r4 = {bf_lo(qr[u][0]), bf_hi(qr[u][0]), bf_lo(qr[u][1]), bf_hi(qr[u][1])};
            f32x4 k4 = {bf_lo(qk[u][0]), bf_hi(qk[u][0]), bf_lo(qk[u][1]), bf_hi(qk[u][1])};
            f32x4 v4 = {bf_lo(qv[u][0]), bf_hi(qv[u][0]), bf_lo(qv[u][1]), bf_hi(qv[u][1])};
            const f32x4 e4 = *(const f32x4*)(sb + SB_WW + o), a4 = *(const f32x4*)(sb + SB_BN + o);
            if (l) {
                const f32x4 vf = {bf_lo(qf[u][0]), bf_hi(qf[u][0]), bf_lo(qf[u][1]), bf_hi(qf[u][1])};
                const f32x4 gm = *(const f32x4*)(sb + SB_KX + o);
                v4 = v4 + (vf - v4) * gm;
            }
            f32x4 w4, kkv, kx, bn, wrv;
            float ss = 0.f, br = 0.f, kr = 0.f, bo = 0.f;
#pragma unroll
            for (int i = 0; i < 4; ++i) { w4[i] = __builtin_amdgcn_exp2f(-1.4426950408889634f * e4[i]); kkv[i] = k4[i] * pkk[i]; ss += kkv[i] * kkv[i]; kx[i] = k4[i] * (1.0f + (a4[i] - 1.0f) * pka[i]); }
            ss = sum16d(ss);
            const float inv = __builtin_amdgcn_rsqf(fmaxf(ss, 1e-24f));
#pragma unroll
            for (int i = 0; i < 4; ++i) { kkv[i] *= inv; bn[i] = -(kkv[i] * a4[i]); wrv[i] = w4[i] * r4[i]; br += bn[i] * r4[i]; kr += kx[i] * r4[i]; bo += r4[i] * kx[i] * prk[i]; }
            br = sum16d(br); kr = sum16d(kr); bo = sum16d(bo);
            { float* kr = sb + SB_KR + tk * 128 + (cgp & 1) * 64 + (cgp >> 1) * 4;
              *(f32x4*)(kr) = (f32x4){kkv[0], wrv[0], kkv[1], wrv[1]};
              *(f32x4*)(kr + 32) = (f32x4){kkv[2], wrv[2], kkv[3], wrv[3]}; }
            *(f32x4*)(sb + SB_BN + o) = bn; *(f32x4*)(sb + SB_WW + o) = w4; *(f32x4*)(sb + SB_KX + o) = kx;
            if (own) { const int o2 = tk * 32 + 4 * (cgp & 7); *(f32x4*)(sb + SB_ADD + o2) = v4 * bo;
#pragma unroll
                for (int i = 0; i < 4; ++i) sb[SB_VV + (4 * (cgp & 7) + i) * VTP + tk] = v4[i]; }
            if (cgp == 0) { sb[SB_SC + tk * 2] = br; sb[SB_SC + tk * 2 + 1] = kr; }
        }
    };
    auto epilogue = [&](int c) {
        const float* sb = L + (c & 1) * SB_SIZE;
        const int tk = ptid >> 3, i4 = 4 * (ptid & 7);
        const f32x4 y4 = *(const f32x4*)(s_y + (c & 1) * TC * 32 + tk * 32 + i4), a4 = *(const f32x4*)(sb + SB_ADD + tk * 32 + i4);
        const size_t off = (rowbase + (size_t)c * TC + tk) * DM + h * 64 + 32 * half + i4;
        u32x2 oy, oa; oy[0] = cvt_pk_bf16(y4[0], y4[1]); oy[1] = cvt_pk_bf16(y4[2], y4[3]); oa[0] = cvt_pk_bf16(a4[0], a4[1]); oa[1] = cvt_pk_bf16(a4[2], a4[3]);
        *(u32x2*)(Yr + off) = oy;
        *(u32x2*)(Ad + off) = oa;
    };
    const int rl = 8 * (w & 3) + (lane >> 3), jc = lane & 7;
    f32x4 st = {0.f, 0.f, 0.f, 0.f}, su = {0.f, 0.f, 0.f, 0.f};
    auto steps16 = [&](const float* sb, float* sy, int t0) {
        auto ldstep = [&](int t) {
            StepOps s;
            s.k0 = *(const f32x4*)(sb + SB_KR + t * 128 + 4 * jc); s.k1 = *(const f32x4*)(sb + SB_KR + t * 128 + 32 + 4 * jc);
            s.k2 = *(const f32x4*)(sb + SB_KR + t * 128 + 64 + 4 * jc); s.k3 = *(const f32x4*)(sb + SB_KR + t * 128 + 96 + 4 * jc);
            s.wa = *(const f32x4*)(sb + SB_WW + t * 64 + 8 * jc); s.wb = *(const f32x4*)(sb + SB_WW + t * 64 + 8 * jc + 4);
            s.ba = *(const f32x4*)(sb + SB_BN + t * 64 + 8 * jc); s.bb = *(const f32x4*)(sb + SB_BN + t * 64 + 8 * jc + 4);
            s.xa = *(const f32x4*)(sb + SB_KX + t * 64 + 8 * jc); s.xb = *(const f32x4*)(sb + SB_KX + t * 64 + 8 * jc + 4);
            return s;
        };
        StepOps cur = ldstep(t0);
        for (int tb = t0; tb < t0 + 16; tb += 8) {
            const f32x4 va = *(const f32x4*)(sb + SB_VV + rl * VTP + tb), vb = *(const f32x4*)(sb + SB_VV + rl * VTP + tb + 4);
            const f32x4 c0 = *(const f32x4*)(sb + SB_SC + 2 * tb), c1 = *(const f32x4*)(sb + SB_SC + 2 * tb + 4), c2 = *(const f32x4*)(sb + SB_SC + 2 * tb + 8), c3 = *(const f32x4*)(sb + SB_SC + 2 * tb + 12);
            const float vis[8] = {va[0], va[1], va[2], va[3], vb[0], vb[1], vb[2], vb[3]};
            const float brs[8] = {c0[0], c0[2], c1[0], c1[2], c2[0], c2[2], c3[0], c3[2]};
            const float krs[8] = {c0[1], c0[3], c1[1], c1[3], c2[1], c2[3], c3[1], c3[3]};
            float yacc = 0.f;
#pragma unroll
            for (int u = 0; u < 8; ++u) {
                const int t = tb + u;
                const StepOps nxt = ldstep(t + 1 < TC ? t + 1 : TC - 1);
                const float vi = vis[u];
                f32x2 p = (f32x2){st[0], st[0]} * (f32x2){cur.k0[0], cur.k0[1]};
                f32x2 q = (f32x2){su[0], su[0]} * (f32x2){cur.k2[0], cur.k2[1]};
                p = (f32x2){st[1], st[1]} * (f32x2){cur.k0[2], cur.k0[3]} + p;
                q = (f32x2){su[1], su[1]} * (f32x2){cur.k2[2], cur.k2[3]} + q;
                p = (f32x2){st[2], st[2]} * (f32x2){cur.k1[0], cur.k1[1]} + p;
                q = (f32x2){su[2], su[2]} * (f32x2){cur.k3[0], cur.k3[1]} + q;
                p = (f32x2){st[3], st[3]} * (f32x2){cur.k1[2], cur.k1[3]} + p;
                q = (f32x2){su[3], su[3]} * (f32x2){cur.k3[2], cur.k3[3]} + q;
                p = p + q;
                float p1 = p[0], p2 = p[1];
                p1 += dpp_xor1(p1); p2 += dpp_xor1(p2);
                p1 += dpp_xor2(p1); p2 += dpp_xor2(p2);
                p1 += dpp_hmir(p1); p2 += dpp_hmir(p2);
                const float y = p2 + p1 * brs[u] + vi * krs[u];
                yacc = (jc == u) ? y : yacc;
                st = st * cur.wa + (cur.ba * p1 + cur.xa * vi);
                su = su * cur.wb + (cur.bb * p1 + cur.xb * vi);
                cur = nxt;
            }
            sy[(tb + jc) * 32 + rl] = yacc;
        }
    };
    constexpr int NCH = SEQ / TC;
    if (prod) issue(0);
    __syncthreads();
    if (prod) lora2(L);
    __syncthreads();
    if (prod) { prep(L); if (1 < NCH) issue(1); }
    __syncthreads();
    for (int c = 0; c < NCH; ++c) {
        float* sb = L + (c & 1) * SB_SIZE;
        float* sn = L + ((c + 1) & 1) * SB_SIZE;
        if (!prod) { __builtin_amdgcn_s_setprio(3); steps16(sb, s_y + (c & 1) * TC * 32, 0); __builtin_amdgcn_s_setprio(0); }
        else { if (c > 0) epilogue(c - 1); if (c + 1 < NCH) lora2(sn); }
        __syncthreads();
        if (!prod) { __builtin_amdgcn_s_setprio(3); steps16(sb, s_y + (c & 1) * TC * 32, 16); __builtin_amdgcn_s_setprio(0); }
        else if (c + 1 < NCH) { prep(sn); if (c + 2 < NCH) issue(c + 2); }
        __syncthreads();
    }
    if (prod) epilogue(NCH - 1);
}

constexpr int KPITCH = 272, VB_OFF = 256 * KPITCH;
__device__ __forceinline__ void attn_phase(PP P, unsigned char* lds, int tid_, int bid_, bool dry) {
    const int tid = tid_, lane = tid & 63, w = tid >> 6, l15 = lane & 15, quad = lane >> 4;
    bf16_t* arr = (bf16_t*)(P->ws + WS_ARR);
    bf16_t* Q = arr + ARR_E; const bf16_t* Kc = arr + 4 * ARR_E; const bf16_t* Vc = arr + 5 * ARR_E;
    float* LSE = (float*)(P->ws + WS_LSE);
    const float LOG2E = 1.4426950408889634f;
    const int bh = bid_ >> 2, sub = bid_ & 3, b = bh >> 3, h = bh & 7;
    const size_t rowb = (size_t)b * SEQ;
    const unsigned ldsbase = (unsigned)(size_t)(LAS unsigned char*)lds;
    const float sc = 0.08838834764831845f * LOG2E;
    const float sl = exp2f(-(float)(h + 1)) * LOG2E;
    u32x4 kpre[4], vpre[4];
    auto decode = [&](int s, int& g, int& r, int& c, bool& first, bool& last) {
        if (s < 8) { g = 0; r = 0; c = sub * 8 + s; first = (s == 0); last = (s == 7); }
        else if (s < 16) { g = 1; r = sub; c = s - 8; first = (s == 8); last = (s == 15); }
        else { g = 2; r = sub * 4 + ((s - 16) >> 1); c = (s - 16) & 1; first = (c == 0); last = (c == 1); }
    };
    const int qi = 16 * w + l15;
    auto qptr = [&](int g, int r, int c) -> bf16_t* {
        const int d = 1 << (2 * g);
        const size_t qrow = rowb + (size_t)(c * 128 + qi) * d + r;
        return Q + (size_t)g * ARR_E + qrow * DM + h * 128;
    };
    bf16x8 qn[4];
    {   int g, r, c; bool f, l; decode(0, g, r, c, f, l);
        const bf16_t* qp0 = qptr(g, r, c);
#pragma unroll
        for (int ks = 0; ks < 4; ++ks) qn[ks] = *(const bf16x8*)(qp0 + ks * 32 + quad * 8);
    }
    const int wodd = w & 1, pb = w & ~1;
    for (int s = 0; s < 24; ++s) {
        int g, r, c; bool first, last;
        decode(s, g, r, c, first, last);
        const int d = 1 << (2 * g);
        auto gload2 = [&](int blk, int dd, int rr, u32x4 (&kk)[4], u32x4 (&vv)[4]) {
#pragma unroll
            for (int i = 0; i < 4; ++i) {
                const int idx = tid + 512 * i, j = idx >> 4, cc = idx & 15;
                if (blk >= 0) {
                    const size_t off = (rowb + (size_t)(blk * 128 + j) * dd + rr) * DM + h * 128 + cc * 8;
                    kk[i] = *(const u32x4*)(Kc + off); vv[i] = *(const u32x4*)(Vc + off);
                } else { kk[i] = (u32x4){0u, 0u, 0u, 0u}; vv[i] = (u32x4){0u, 0u, 0u, 0u}; }
            }
        };
        auto gload = [&](int blk, u32x4 (&kk)[4], u32x4 (&vv)[4]) { gload2(blk, d, r, kk, vv); };
        auto lstore = [&](int slot, const u32x4 (&kk)[4], const u32x4 (&vv)[4]) {
#pragma unroll
            for (int i = 0; i < 4; ++i) {
                const int idx = tid + 512 * i, j = idx >> 4, cc = idx & 15;
                *(u32x4*)(lds + (slot * 128 + j) * KPITCH + cc * 16) = kk[i];
                *(u32x4*)(lds + VB_OFF + (slot * 128 + j) * KPITCH + cc * 16) = vv[i];
            }
        };
        if (first) {
            if (s == 0) gload(c, kpre, vpre);
            __syncthreads();
            lstore(c & 1, kpre, vpre);
            gload(c - 1, kpre, vpre); lstore((c - 1) & 1, kpre, vpre);
            __syncthreads();
        }
        bf16_t* qp = qptr(g, r, c);
        const size_t qrow = rowb + (size_t)(c * 128 + qi) * d + r;
        bf16x8 qf[4];
#pragma unroll
        for (int ks = 0; ks < 4; ++ks) qf[ks] = qn[ks];
        if (s + 1 < 24) {
            int g2, r2, c2; bool f2, l2; decode(s + 1, g2, r2, c2, f2, l2);
            const bf16_t* qp2 = qptr(g2, r2, c2);
#pragma unroll
            for (int ks = 0; ks < 4; ++ks) qn[ks] = *(const bf16x8*)(qp2 + ks * 32 + quad * 8);
        }
        if (!last) gload(c + 1, kpre, vpre);
        else if (s + 1 < 24) {
            int g2, r2, c2; bool f2, l2; decode(s + 1, g2, r2, c2, f2, l2);
            gload2(c2, 1 << (2 * g2), r2, kpre, vpre);
        }
        const int xr = (c & 1) ? 0 : 8;
        f32x4 sv[10];
#pragma unroll
        for (int tt = 0; tt < 10; ++tt) {
            f32x4 acc = {0.f, 0.f, 0.f, 0.f};
            const unsigned char* kb = lds + (16 * ((pb + tt) ^ xr) + l15) * KPITCH + quad * 16;
            const bool outside = (tt == 0) ? (wodd != 0) : ((tt == 9) ? (wodd == 0) : false);
            if (!outside) {
#pragma unroll
                for (int ks = 0; ks < 4; ++ks) {
                    const bf16x8 a = *(const bf16x8*)(kb + ks * 64);
                    acc = __builtin_amdgcn_mfma_f32_16x16x32_bf16(a, qf[ks], acc, 0, 0, 0);
                }
            }
            sv[tt] = acc;
        }
        const float b0 = -sl * (float)(128 + l15 + 16 * wodd - 4 * quad);
        const float sl16 = 16.0f * sl;
        float mx = -INFINITY;
#pragma unroll
        for (int tt = 0; tt < 10; ++tt) {
            const float bt = b0 + sl16 * (float)tt;
            const bool tile_ok = (c > 0) || (pb + tt >= 8);
#pragma unroll
            for (int e = 0; e < 4; ++e) {
                float sx = sv[tt][e] * sc + (bt + sl * (float)e);
                if (tt < 2 || tt > 7) {
                    const int delta = 128 + l15 + 16 * wodd - 16 * tt - 4 * quad - e;
                    sx = ((delta >= 0) && (delta <= 128) && tile_ok) ? sx : -INFINITY;
                } else {
                    sx = tile_ok ? sx : -INFINITY;
                }
                sv[tt][e] = sx; mx = fmaxf(mx, sx);
            }
        }
        mx = fmaxf(mx, __shfl_xor(mx, 16, 64)); mx = fmaxf(mx, __shfl_xor(mx, 32, 64));
        float lsum = 0.f;
#pragma unroll
        for (int tt = 0; tt < 10; ++tt)
#pragma unroll
            for (int e = 0; e < 4; ++e) { const float p = __builtin_amdgcn_exp2f(sv[tt][e] - mx); sv[tt][e] = p; lsum += p; }
        lsum += __shfl_xor(lsum, 16, 64); lsum += __shfl_xor(lsum, 32, 64);
        bf16x8 pf[5];
#pragma unroll
        for (int pp = 0; pp < 5; ++pp) {
            u32x4 o; o[0] = cvt_pk_bf16(sv[2 * pp][0], sv[2 * pp][1]); o[1] = cvt_pk_bf16(sv[2 * pp][2], sv[2 * pp][3]);
            o[2] = cvt_pk_bf16(sv[2 * pp + 1][0], sv[2 * pp + 1][1]); o[3] = cvt_pk_bf16(sv[2 * pp + 1][2], sv[2 * pp + 1][3]);
            pf[pp] = __builtin_bit_cast(bf16x8, o);
        }
        const float invl = __builtin_amdgcn_rcpf(lsum);
        unsigned va[5];
#pragma unroll
        for (int pp = 0; pp < 5; ++pp) va[pp] = ldsbase + VB_OFF + (16 * ((pb + 2 * pp) ^ xr) + 4 * quad + (l15 >> 2)) * KPITCH + 16 * (l15 & 3);
#define TR_ISSUE(T, DT) asm volatile( \
                "ds_read_b64_tr_b16 %0, %10 offset:%15\n\t" "ds_read_b64_tr_b16 %1, %10 offset:%16\n\t" \
                "ds_read_b64_tr_b16 %2, %11 offset:%15\n\t" "ds_read_b64_tr_b16 %3, %11 offset:%16\n\t" \
                "ds_read_b64_tr_b16 %4, %12 offset:%15\n\t" "ds_read_b64_tr_b16 %5, %12 offset:%16\n\t" \
                "ds_read_b64_tr_b16 %6, %13 offset:%15\n\t" "ds_read_b64_tr_b16 %7, %13 offset:%16\n\t" \
                "ds_read_b64_tr_b16 %8, %14 offset:%15\n\t" "ds_read_b64_tr_b16 %9, %14 offset:%16" \
                : "=&v"(T[0]), "=&v"(T[1]), "=&v"(T[2]), "=&v"(T[3]), "=&v"(T[4]), "=&v"(T[5]), "=&v"(T[6]), "=&v"(T[7]), "=&v"(T[8]), "=&v"(T[9]) \
                : "v"(va[0]), "v"(va[1]), "v"(va[2]), "v"(va[3]), "v"(va[4]), "i"(((DT) >> 1) * 64 + ((DT) & 1) * 8), "i"(((DT) >> 1) * 64 + ((DT) & 1) * 8 + 16 * KPITCH) : "memory")
#define TR_WAIT(T, N) asm volatile("s_waitcnt lgkmcnt(" #N ")" \
                : "+v"(T[0]), "+v"(T[1]), "+v"(T[2]), "+v"(T[3]), "+v"(T[4]), "+v"(T[5]), "+v"(T[6]), "+v"(T[7]), "+v"(T[8]), "+v"(T[9]) :: "memory")
        s16x4 ta[10], tb[10];
        TR_ISSUE(ta, 0);
#pragma unroll
        for (int dt = 0; dt < 8; dt += 2) {
            TR_ISSUE(tb, dt + 1);
            TR_WAIT(ta, 10);
            f32x4 acc0 = {0.f, 0.f, 0.f, 0.f};
#pragma unroll
            for (int pp = 0; pp < 5; ++pp) acc0 = __builtin_amdgcn_mfma_f32_16x16x32_bf16(__builtin_shufflevector(ta[2 * pp], ta[2 * pp + 1], 0, 1, 2, 3, 4, 5, 6, 7), pf[pp], acc0, 0, 0, 0);
            if (dt + 2 < 8) { TR_ISSUE(ta, dt + 2); TR_WAIT(tb, 10); } else { TR_WAIT(tb, 0); }
            f32x4 acc1 = {0.f, 0.f, 0.f, 0.f};
#pragma unroll
            for (int pp = 0; pp < 5; ++pp) acc1 = __builtin_amdgcn_mfma_f32_16x16x32_bf16(__builtin_shufflevector(tb[2 * pp], tb[2 * pp + 1], 0, 1, 2, 3, 4, 5, 6, 7), pf[pp], acc1, 0, 0, 0);
            {
                u32x4 o; o[0] = cvt_pk_bf16(acc0[0] * invl, acc0[1] * invl); o[1] = cvt_pk_bf16(acc0[2] * invl, acc0[3] * invl);
                o[2] = cvt_pk_bf16(acc1[0] * invl, acc1[1] * invl); o[3] = cvt_pk_bf16(acc1[2] * invl, acc1[3] * invl);
                if (!dry) *(u32x4*)(qp + 16 * dt + 8 * quad) = o;
            }
        }
#undef TR_ISSUE
#undef TR_WAIT
        if (quad == 0) LSE[((size_t)g * T_TOK + qrow) * 8 + h] = 0.6931471805599453f * (mx + log2f(lsum));
        if (!last) {
            __syncthreads();
            lstore((c + 1) & 1, kpre, vpre);
            __syncthreads();
        }
    }
}

#define XB_TMO      128
#define XB_XCNT(j)  (256  + 64 * (j))
#define XB_XSUB(j)  (1280 + 64 * (j))
#define XB_XGEN(j)  (2304 + 64 * (j))
#define XB_TOP      3328
#define XB_TOPGEN   3392
#define XCD_BAR_WORDS 3456
#define XB_SPIN_CAP (1u << 20)
__device__ __forceinline__ unsigned xb_ld(unsigned* p)              { return __hip_atomic_load(p, __ATOMIC_RELAXED, __HIP_MEMORY_SCOPE_AGENT); }
__device__ __forceinline__ unsigned xb_add(unsigned* p, unsigned v) { return __hip_atomic_fetch_add(p, v, __ATOMIC_RELAXED, __HIP_MEMORY_SCOPE_AGENT); }
__device__ __forceinline__ unsigned xb_xcc_id() { return (unsigned)__builtin_amdgcn_s_getreg((3 << 11) | 20) & 0xFu; }
#define XB_SPIN(cond, bar) do { unsigned _sp = 0; while (cond) { __builtin_amdgcn_s_sleep(1); \
    if ((++_sp & 255u) == 0u) { if (xb_ld(&(bar)[XB_TMO])) break; if (_sp > XB_SPIN_CAP) { atomicAdd(&(bar)[XB_TMO], 1u); break; } } } } while (0)
struct XcdBarrier { unsigned* bar; unsigned x; volatile LAS unsigned* st; };
__device__ __forceinline__ XcdBarrier xcd_barrier_post(unsigned* bar, volatile LAS unsigned* st) {
    XcdBarrier b; b.bar = bar; b.x = xb_xcc_id(); b.st = st;
    if (threadIdx.x == 0) (void)xb_add(&bar[XB_XCNT(b.x)], 1u);
    return b;
}
__device__ __forceinline__ void xcd_barrier_complete(unsigned* bar, unsigned x, unsigned& nloc, unsigned& nx) {
    const unsigned G = gridDim.x * gridDim.y * gridDim.z;
    unsigned sum, cnt, mine, sp = 0u;
    for (;;) {
        sum = 0u; cnt = 0u; mine = 0u;
#pragma unroll
        for (unsigned j = 0; j < 16; ++j) { const unsigned c = xb_ld(&bar[XB_XCNT(j)]); sum += c; cnt += (c > 0u) ? 1u : 0u; mine = (j == x) ? c : mine; }
        if (sum == G) break;
        __builtin_amdgcn_s_sleep(1);
        if ((++sp & 255u) == 0u) { if (xb_ld(&bar[XB_TMO])) break; if (sp > XB_SPIN_CAP) { atomicAdd(&bar[XB_TMO], 1u); break; } }
    }
    nloc = mine > 0u ? mine : 1u; nx = cnt > 0u ? cnt : 1u;
}
__device__ __forceinline__ void xcd_barrier(const XcdBarrier& b) {
    asm volatile("s_waitcnt vmcnt(0)" ::: "memory");
    __syncthreads();
    if (threadIdx.x == 0) {
        unsigned* bar = b.bar;
        __builtin_amdgcn_s_waitcnt(0);
        unsigned nloc = b.st[0], nx = b.st[1];
        if (nloc == 0u) { xcd_barrier_complete(bar, b.x, nloc, nx); b.st[0] = nloc; b.st[1] = nx; }
        const unsigned old = xb_add(&bar[XB_XSUB(b.x)], 1u);
        const unsigned gen = old / nloc;
        if (old + 1u == (gen + 1u) * nloc) {
            __builtin_amdgcn_fence(__ATOMIC_RELEASE, "agent");
            asm volatile("s_waitcnt vmcnt(0)" ::: "memory");
            const unsigned og = xb_add(&bar[XB_TOP], 1u);
            const unsigned tg = og / nx;
            if (og + 1u == (tg + 1u) * nx) xb_add(&bar[XB_TOPGEN], 1u);
            else XB_SPIN(xb_ld(&bar[XB_TOPGEN]) == tg, bar);
            __builtin_amdgcn_fence(__ATOMIC_ACQUIRE, "agent");
            xb_add(&bar[XB_XGEN(b.x)], 1u);
            asm volatile("s_waitcnt vmcnt(0)" ::: "memory");
        } else {
            XB_SPIN(xb_ld(&bar[XB_XGEN(b.x)]) == gen, bar);
            __builtin_amdgcn_fence(__ATOMIC_ACQUIRE, "agent");
            asm volatile("s_waitcnt vmcnt(0)" ::: "memory");
        }
    }
    __syncthreads();
}

__device__ __forceinline__ void run_phase(PP P, int ph, unsigned char* lds, bool dry) {
    int tid_ = threadIdx.x, bid_ = blockIdx.x;
    asm volatile("" : "+v"(tid_));
    asm volatile("" : "+s"(bid_));
    bf16_t* W = (bf16_t*)(P->ws + WS_W);
    bf16_t* arr = (bf16_t*)(P->ws + WS_ARR);
    bf16_t* Pb = (bf16_t*)(P->ws + WS_P);
    bf16_t* Lb = (bf16_t*)(P->ws + WS_L);
    bf16_t* A0 = arr; bf16_t* A1 = arr + ARR_E; bf16_t* A2 = arr + 2 * ARR_E; bf16_t* A3 = arr + 3 * ARR_E; bf16_t* A4 = arr + 4 * ARR_E; bf16_t* A5 = arr + 5 * ARR_E;
    LAS unsigned char* l3 = (LAS unsigned char*)lds;
    EpiArgs ea; ea.mode = 0; ea.pad_ = 0; ea.o0 = nullptr; ea.o1 = nullptr; ea.o2 = nullptr; ea.i0 = nullptr; ea.f0 = nullptr; ea.f1 = nullptr; ea.f2 = nullptr; ea.hout = P->out; ea.hin = P->out; ea.lse = nullptr;
    int kind = 0, pc_layer = -1; bool pc_zero = false, zeroL = false, gn = false; int scan_l = 0;
    const bf16_t* gA = nullptr; const bf16_t* gB = nullptr; int gK = 1024, nseg = 1, pm1 = 0, pn1 = 0, nN0 = 4, nN1 = 0;
    const float* hin = P->out; const float* ng = nullptr; const float* mu0 = nullptr; const float* mu1 = nullptr; bf16_t* X1 = nullptr;
    float* ssq = (float*)(P->ws + WS_SSQ);
    ea.ssq_out = nullptr; ea.ssq_in = ssq + 8 * T_TOK; ea.hb = A0;
    bf16_t* Lcur = Lb;
    bf16_t* X2 = nullptr; const float* mu2 = nullptr;
    bool ple2 = false; const bf16_t* gB2 = nullptr; EpiArgs eb = ea;
    int pm2 = 0, pn2 = 0, nN2 = 0;
    if (ph == 0) kind = 7;
    else if (ph <= 18) {
        const int l = (ph - 1) / 9, s = (ph - 1) % 9 + 1;
        const float* hl = (l == 0) ? P->in[0] : P->out;
        const float* mu = P->in[3] + l * 6 * 1024;
        bf16_t* Wl = W + l * RW_STRIDE;
        bf16_t* V = (l == 0) ? A4 : A5;
        bf16_t* X2l = (l == 0) ? A5 : (bf16_t*)(P->ws + WS_A6);
        if (l == 1) Lcur = W;
        hin = hl; ng = P->in[2] + l * 1024; scan_l = l;
        switch (s) {
        case 1: kind = 3; mu0 = mu; mu1 = mu + 1024; X1 = A1; break;
        case 2: kind = 1; ea.mode = M_SPLIT; ea.o0 = A2; gA = A0; gB = Wl + RW_WRK; nseg = 2; pm1 = 128; pn1 = 4; nN0 = 4; nN1 = 4; break;
        case 3: kind = 3; mu0 = mu + 2 * 1024; mu1 = mu + 4 * 1024; mu2 = mu + 5 * 1024; X1 = A1; X2 = X2l; break;
        case 4: kind = 1; ea.mode = M_VLW; ea.o0 = V; ea.o1 = Lcur; gA = A0; gB = Wl + RW_WVW; nseg = 3; pm1 = 128; pn1 = 5; nN0 = (l == 0 ? 4 : 5); nN1 = 1;
                pm2 = (l == 0) ? 640 : 768; pn2 = 6; nN2 = 1; break;
        case 5: kind = 5; break;
        case 6: kind = 3; mu0 = mu + 3 * 1024; gn = true; break;
        case 7: kind = 1; ea.mode = M_G; ea.o0 = A2; gA = A0; gB = Wl + RW_WG; break;
        case 8: kind = 2; ea.mode = M_OUT; ea.hin = hl; ea.hb = A3; ea.ssq_out = ssq + (2 * l) * T_TOK; gA = A2; gB = Wl + RW_WO; pc_layer = l; break;
        default: kind = 1; ea.mode = M_PGATE; ea.o0 = A1; ea.ssq_in = ssq + (2 * l) * T_TOK; gA = A3; gB = W + PLE_BASE + l * PLE_STRIDE;
                 ple2 = true; eb = ea; eb.mode = M_PLE; eb.i0 = A1; eb.ssq_in = nullptr; eb.ssq_out = (l == 0) ? nullptr : ssq + (2 * l + 1) * T_TOK; if (l == 0) eb.hb = nullptr; gB2 = W + PLE_BASE + l * PLE_STRIDE + PLE_WP; break;
        }
    } else if (ph == 19) { kind = 1; ea.mode = M_SPLIT; ea.o0 = A4; ea.ssq_in = ssq + 3 * T_TOK; gA = A0; gB = W + KV_BASE; nN0 = 8; }
    else if (ph <= 29) {
        const int q = (ph - 20) / 5, s = (ph - 20) % 5 + 1;
        const int gl = 2 + q;
        bf16_t* Wa = W + ATT_BASE + q * ATT_STRIDE;
        const float* sin_ = ssq + (q == 0 ? 3 : 5) * T_TOK;
        switch (s) {
        case 1: kind = 1; ea.mode = M_SPLIT; ea.o0 = A1; ea.ssq_in = sin_; gA = A0; gB = Wa; nN0 = 12; pc_layer = gl; break;
        case 2: kind = 6; break;
        case 3: kind = 1; ea.mode = M_AGATE; ea.o0 = A1; ea.ssq_in = sin_; ea.lse = (const float*)(P->ws + WS_LSE); gA = A0; gB = Wa + (size_t)3072 * 1024; break;
        case 4: kind = 2; ea.mode = M_OUT; ea.hb = A3; ea.ssq_out = ssq + (4 + 2 * q) * T_TOK; gA = A1; gB = Wa + ATT_WO; break;
        default: kind = 1; ea.mode = M_PGATE; ea.o0 = A2; ea.ssq_in = ssq + (4 + 2 * q) * T_TOK; gA = A3; gB = W + PLE_BASE + gl * PLE_STRIDE;
                 ple2 = true; eb = ea; eb.mode = M_PLE; eb.i0 = A2; eb.ssq_in = nullptr; eb.ssq_out = ssq + (5 + 2 * q) * T_TOK; gB2 = W + PLE_BASE + gl * PLE_STRIDE + PLE_WP; break;
        }
    } else kind = 8;

    if (kind == 1 || kind == 2) {
        pg8::Gemm g{gA, gB, gK};
        pg8::SegOrder S; S.nseg = nseg; S.G = gridDim.x; S.c = bid_; S.pm1 = pm1; S.pn1 = pn1; S.nN0 = nN0; S.nN1 = nN1; S.pm2 = pm2; S.pn2 = pn2; S.nN2 = nN2;
#ifndef NO_GP
        const int npass = ple2 ? 2 : 1;
        for (int pass = 0; pass < npass; ++pass) {
            Epi<true> E; E.a = ea;
            if (pass == 1) {
                asm volatile("s_waitcnt vmcnt(0)" ::: "memory");
                __syncthreads();
                g.A = Pb; g.Bt = gB2; g.K = 256; E.a = eb;
            }
            pg8::gemm_phase<Epi<true>, pg8::SegOrder>(l3, g, S, E, tid_);
        }
#endif
    } else if (kind == 3) {
        prep_shift(hin, ng, mu0, mu1, mu2, A0, X1, X2, tid_, bid_, A5, A1, P->in[17] + scan_l * 1024, P->in[18] + scan_l * 1024, gn ? A2 : nullptr);
    } else if (kind == 4) {
        prep_plain(hin, ng, A0, tid_, bid_);
    }
#ifndef NO_SCAN
    else if (kind == 5) scan_phase(P, scan_l, (float*)lds, tid_, bid_, Lcur);
#endif
#ifndef NO_ATTN
    else if (kind == 6) attn_phase(P, lds, tid_, bid_, dry);
#endif
    else if (kind == 7) convert_phase(P, (float*)lds, tid_, bid_);
    else if (kind == 8) final_norm(P->out, P->in[28], ssq + 7 * T_TOK, tid_, bid_);
    if (pc_layer >= 0) pconv(P, pc_layer, false, tid_, bid_);
}

__global__ void __launch_bounds__(512, 2) yoco_mega(Params P) {
    extern __shared__ __attribute__((aligned(16))) unsigned char lds[];
    cg::grid_group grid = cg::this_grid();
    volatile LAS unsigned* st = (volatile LAS unsigned*)((LAS unsigned char*)lds + (LDS_BYTES - 16));
    if (threadIdx.x == 0) { st[0] = 0u; st[1] = 0u; }
    __syncthreads();
    const XcdBarrier xb = xcd_barrier_post((unsigned*)(P.ws + WS_BAR), st);
    for (int ph = P.ph_lo; ph < P.ph_hi; ++ph) {
        PP Pk = (PP)__builtin_amdgcn_kernarg_segment_ptr();
        asm volatile("" : "+s"(Pk));
        int nrep = 1;
        if (PROBE_MODE == 1 && (ph == 2 || ph == 4)) nrep = 2;
        if (PROBE_MODE == 2 && (ph == 1 || ph == 3 || ph == 6)) nrep = 2;
        if (PROBE_MODE == 3 && ph == 5) nrep = 2;
        for (int rep = 0; rep < nrep; ++rep) {
            run_phase(Pk, ph, lds, rep + 1 < nrep);
            if (rep + 1 < nrep) xcd_barrier(xb);
        }
        if (ph + 1 < P.ph_hi) { if (ph == 0) grid.sync(); else xcd_barrier(xb); }
    }
}

extern "C" void kernel_launch(void* const* d_in, const int* in_sizes, int n_in, void* d_out, int out_size, void* d_ws, size_t ws_size, hipStream_t stream) {
    static int grid = 0;
    if (grid == 0) {
        int dev = 0, cus = 0, per_cu = 0;
        hipGetDevice(&dev);
        hipDeviceGetAttribute(&cus, hipDeviceAttributeMultiprocessorCount, dev);
        if (hipFuncSetAttribute((const void*)yoco_mega, hipFuncAttributeMaxDynamicSharedMemorySize, LDS_BYTES) != hipSuccess) fprintf(stderr, "hipFuncSetAttribute failed\n");
        hipOccupancyMaxActiveBlocksPerMultiprocessor(&per_cu, (const void*)yoco_mega, 512, LDS_BYTES);
        if (per_cu < 1) fprintf(stderr, "occupancy query says %d blocks per CU\n", per_cu);
        (void)hipGetLastError();
        grid = cus > 0 ? cus : 256;
        if (grid > 256) grid = 256;
        if (ws_size < 512 * MiB) fprintf(stderr, "workspace too small: %zu\n", ws_size);
    }
    Params p;
    __builtin_memset(&p, 0, sizeof(p));
    for (int i = 0; i < 29; ++i) p.in[i] = (const float*)d_in[i];
    p.out = (float*)d_out; p.ws = (unsigned char*)d_ws; p.ph_lo = 0; p.ph_hi = NPH;
    if (hipMemsetAsync((char*)d_ws + WS_BAR, 0, XCD_BAR_WORDS * 4, stream) != hipSuccess) fprintf(stderr, "memset failed\n");
    void* args[] = {&p};
    hipError_t e = hipLaunchCooperativeKernel((const void*)yoco_mega, dim3(grid), dim3(512), args, LDS_BYTES, stream);
    if (e != hipSuccess) fprintf(stderr, "cooperative launch failed: %s (grid %d)\n", hipGetErrorString(e), grid);
}
```

```cpp
#include <hip/hip_runtime.h>
#include <hip/hip_cooperative_groups.h>
#include <cstdio>
namespace cg = cooperative_groups;

#define LAS __attribute__((address_space(3)))
typedef unsigned short bf16_t;
typedef short bf16x8 __attribute__((ext_vector_type(8)));
typedef short s16x4 __attribute__((ext_vector_type(4)));
typedef float f32x4 __attribute__((ext_vector_type(4)));
typedef unsigned u32x4 __attribute__((ext_vector_type(4)));
typedef unsigned u32x2 __attribute__((ext_vector_type(2)));

constexpr int T_TOK = 32768, DM = 1024, SEQ = 4096;
constexpr size_t ARR_E = (size_t)T_TOK * DM;
constexpr size_t MiB = 1048576;
constexpr size_t WS_W = 0, WS_BAR = 60 * MiB, WS_SSQ = 60 * MiB + 65536, WS_ARR = 62 * MiB, WS_P = 446 * MiB, WS_L = 462 * MiB, WS_LSE = 462 * MiB, ARR_B = 64 * MiB;
constexpr size_t WS_A6 = 446 * MiB;
constexpr int LDS_BYTES = 139264;
constexpr int NPH = 31;
constexpr int LP = 192;
constexpr int PROBE_MODE = 0;
constexpr size_t RW_STRIDE = 6815744, RW_WRK = 0, RW_WVW = 2097152, RW_WA1 = 3670016, RW_W2C = 3932160, RW_WG = 4718592, RW_WO = 5767168;
constexpr size_t PLE_BASE = 13631488, PLE_STRIDE = 1310720, PLE_WP = 1048576;
constexpr size_t KV_BASE = 18874368, ATT_BASE = 20971520, ATT_STRIDE = 5242880, ATT_WO = 4194304;

struct Params {
    const float* in[29];
    float* out;
    unsigned char* ws;
    int ph_lo, ph_hi;
};

typedef const __attribute__((address_space(4))) Params* PP;

typedef __bf16 bf16x2_t __attribute__((ext_vector_type(2)));
typedef float f32x2_t __attribute__((ext_vector_type(2)));
__device__ __forceinline__ unsigned cvt_pk_bf16(float lo, float hi) { const f32x2_t v = {lo, hi}; return __builtin_bit_cast(unsigned, __builtin_convertvector(v, bf16x2_t)); }
__device__ __forceinline__ float bf_lo(unsigned u) { return __uint_as_float(u << 16); }
__device__ __forceinline__ float bf_hi(unsigned u) { return __uint_as_float(u & 0xffff0000u); }
__device__ __forceinline__ float sigmoidf_(float z) { return __builtin_amdgcn_rcpf(1.0f + __builtin_amdgcn_exp2f(-1.4426950408889634f * z)); }
__device__ __forceinline__ float siluf_(float z) { return z * __builtin_amdgcn_rcpf(1.0f + __builtin_amdgcn_exp2f(-1.4426950408889634f * z)); }
__device__ __forceinline__ float dpp_xor1(float v) { return __builtin_bit_cast(float, __builtin_amdgcn_update_dpp(0, __builtin_bit_cast(int, v), 0xB1, 0xf, 0xf, false)); }
__device__ __forceinline__ float dpp_xor2(float v) { return __builtin_bit_cast(float, __builtin_amdgcn_update_dpp(0, __builtin_bit_cast(int, v), 0x4E, 0xf, 0xf, false)); }
__device__ __forceinline__ float dpp_hmir(float v) { return __builtin_bit_cast(float, __builtin_amdgcn_update_dpp(0, __builtin_bit_cast(int, v), 0x141, 0xf, 0xf, false)); }
__device__ __forceinline__ float dpp_mir(float v) { return __builtin_bit_cast(float, __builtin_amdgcn_update_dpp(0, __builtin_bit_cast(int, v), 0x140, 0xf, 0xf, false)); }
__device__ __forceinline__ float sum16d(float v) { v += dpp_xor1(v); v += dpp_xor2(v); v += dpp_hmir(v); v += dpp_mir(v); return v; }
__device__ __forceinline__ float wave_sum(float v) {
#pragma unroll
    for (int o = 32; o >= 1; o >>= 1) v += __shfl_xor(v, o, 64);
    return v;
}
__device__ __forceinline__ float sum16(float v) {
    v += __shfl_xor(v, 1, 64); v += __shfl_xor(v, 2, 64); v += __shfl_xor(v, 4, 64); v += __shfl_xor(v, 8, 64); return v;
}

namespace pg8 {
constexpr int BM = 256, BK = 64, HALF = 128, HTB = HALF * BK * 2, NXCD = 8, WGM = 8;
__device__ __forceinline__ int lds_byte(int r, int c) { const int st = (r >> 4) * 2 + (c >> 5), rr = r & 15, cc = c & 31, ob = rr * 64 + cc * 2; return st * 1024 + (ob ^ (((ob >> 9) & 1) << 5)); }
__device__ __forceinline__ void stage_rc(int b, int& R, int& C) { const int st = b / 1024, sb = b % 1024, swz = sb ^ (((sb >> 9) & 1) << 5); R = (st >> 1) * 16 + swz / 64; C = (st & 1) * 32 + (swz % 64) / 2; }
__device__ __forceinline__ int perm32(int rho) { const int n = rho >> 4, i = rho & 15; return 8 * (i >> 2) + 4 * n + (i & 3); }
struct Unit { int pm, pn; };
struct Gemm { const bf16_t* A; const bf16_t* Bt; int K; };

struct SegOrder {
    int nseg, G, c;
    int pm1, pn1, pm2, pn2, nN0, nN1, nN2;
    __device__ __forceinline__ bool next(int i, Unit& u) const {
        int L = i * G + c;
        int s = 0;
        const int u0 = 128 * nN0, u1 = 128 * nN1;
        if (L >= u0) { if (nseg < 2) return false; L -= u0; s = 1;
            if (L >= u1) { if (nseg < 3) return false; L -= u1; s = 2; if (L >= 128 * nN2) return false; } }
        const int nM = 128, nn = (s == 0) ? nN0 : (s == 1 ? nN1 : nN2), nwg = nM * nn;
        int wgid = L; { const int q = nwg / NXCD, r = nwg % NXCD, xcd = wgid % NXCD, off = wgid / NXCD; wgid = (xcd < r ? xcd * (q + 1) : r * (q + 1) + (xcd - r) * q) + off; }
        const int nig = WGM * nn, gid = wgid / nig, fm = gid * WGM, gsz = (nM - fm) < WGM ? (nM - fm) : WGM;
        u.pm = ((s == 0) ? 0 : (s == 1 ? pm1 : pm2)) + fm + ((wgid % nig) % gsz); u.pn = ((s == 0) ? 0 : (s == 1 ? pn1 : pn2)) + (wgid % nig) / gsz; return true;
    }
};

template <class Epi, class Sched>
__device__ __forceinline__ void gemm_phase(LAS unsigned char* lds, const Gemm g, const Sched& S, const Epi& E, int tid_) {
    const int tid = tid_, wid = __builtin_amdgcn_readfirstlane(tid >> 6), lane = tid & 63, wr = wid >> 2, wc = wid & 3, fr = lane & 15, fq = lane >> 4;
    const int K = g.K, nt = K / BK;
    unsigned voffA[2], voffB[2];
#pragma unroll
    for (int i = 0; i < 2; ++i) { int R, C; stage_rc(tid * 16 + i * 8192, R, C); const int Rb = Epi::PERM ? ((R & ~31) + perm32(R & 31)) : R;
        voffA[i] = (unsigned)(R * K + C) * 2u; voffB[i] = (unsigned)(Rb * K + C) * 2u; }
    const size_t kstep = (size_t)(BK * 2);
    const size_t hstep = (size_t)HALF * K * 2;
    const size_t tstep = 2 * hstep;
    const unsigned ldsw = (unsigned)wid * 1024u;
    const int aoff = lds_byte(wr * 64 + fr, fq * 8), boff = lds_byte(wc * 32 + fr, fq * 8);
#define PG8_SA(b, h) (((b) * 2 + (h)) * HTB)
#define PG8_SB(b, h) ((4 + (b) * 2 + (h)) * HTB)
#define PG8_STAGE(bufoff, gbase, voff) do { _Pragma("unroll") for (int _i = 0; _i < 2; ++_i) \
        __builtin_amdgcn_global_load_lds((const unsigned*)((const char*)(gbase) + (voff)[_i]), (LAS unsigned*)(lds + (bufoff) + ldsw + _i * 8192), 16, 0, 0); } while (0)
#define PG8_LDA(dst, b, h) do { _Pragma("unroll") for (int m = 0; m < 4; ++m) _Pragma("unroll") for (int k = 0; k < 2; ++k) dst[m][k] = *(const LAS bf16x8*)(lds + PG8_SA(b, h) + aoff + m * 2048 + k * 1024); } while (0)
#define PG8_LDB(dst, b, h) do { _Pragma("unroll") for (int n = 0; n < 2; ++n) _Pragma("unroll") for (int k = 0; k < 2; ++k) dst[n][k] = *(const LAS bf16x8*)(lds + PG8_SB(b, h) + boff + n * 2048 + k * 1024); } while (0)
#define PG8_MMA(ai, bj, At, Bt) do { __builtin_amdgcn_s_setprio(1); _Pragma("unroll") for (int m = 0; m < 4; ++m) _Pragma("unroll") for (int n = 0; n < 2; ++n) _Pragma("unroll") for (int k = 0; k < 2; ++k) \
        acc[ai][bj][m][n] = __builtin_amdgcn_mfma_f32_16x16x32_bf16(Bt[n][k], At[m][k], acc[ai][bj][m][n], 0, 0, 0); __builtin_amdgcn_s_setprio(0); } while (0)
#define PG8_WAIT_V(n) asm volatile("s_waitcnt vmcnt(" #n ")" ::: "memory")
#define PG8_WAIT_L(n) asm volatile("s_waitcnt lgkmcnt(" #n ")" ::: "memory")
#define PG8_BAR __builtin_amdgcn_s_barrier()
#define PG8_SCHED __builtin_amdgcn_sched_barrier(0)
    Unit cur, nxt; int ui = 0;
    if (!S.next(0, cur)) return;
    f32x4 acc[2][2][4][2];
#pragma unroll
    for (int a = 0; a < 2; ++a)
#pragma unroll
        for (int b = 0; b < 2; ++b)
#pragma unroll
            for (int m = 0; m < 4; ++m)
#pragma unroll
                for (int n = 0; n < 2; ++n) acc[a][b][m][n] = (f32x4){0.f, 0.f, 0.f, 0.f};
    bf16x8 At[4][2], B0[2][2], B1[2][2];
    const char* cA = (const char*)g.A + (size_t)cur.pm * tstep; const char* cB = (const char*)g.Bt + (size_t)cur.pn * tstep;
    PG8_STAGE(PG8_SB(0, 0), cB, voffB); PG8_STAGE(PG8_SA(0, 0), cA, voffA); PG8_STAGE(PG8_SB(0, 1), cB + hstep, voffB); PG8_STAGE(PG8_SA(0, 1), cA + hstep, voffA);
    if (wr == 1) PG8_BAR;
    PG8_WAIT_V(4); PG8_BAR;
    PG8_STAGE(PG8_SB(1, 0), cB + kstep, voffB); PG8_STAGE(PG8_SA(1, 0), cA + kstep, voffA); PG8_STAGE(PG8_SB(1, 1), cB + hstep + kstep, voffB);
    PG8_WAIT_V(6); PG8_BAR;
    for (;;) {
        const bool has_next = S.next(ui + 1, nxt);
        const char* nA = has_next ? (const char*)g.A + (size_t)nxt.pm * tstep : cA; const char* nB = has_next ? (const char*)g.Bt + (size_t)nxt.pn * tstep : cB;
        for (int t = 0; t < nt; t += 2) {
            const bool last = (t == nt - 2);
            const char* a1 = cA + (size_t)(t + 1) * kstep;
            const char* a2 = last ? nA : cA + (size_t)(t + 2) * kstep; const char* b2 = last ? nB : cB + (size_t)(t + 2) * kstep;
            const char* a3 = a2 + kstep; const char* b3 = b2 + kstep;
            PG8_LDB(B0, 0, 0); PG8_SCHED; PG8_LDA(At, 0, 0); PG8_STAGE(PG8_SA(1, 1), a1 + hstep, voffA);
            PG8_WAIT_L(8); PG8_BAR; PG8_WAIT_L(0); PG8_MMA(0, 0, At, B0); PG8_BAR; PG8_SCHED;
            PG8_LDB(B1, 0, 1); PG8_STAGE(PG8_SB(0, 0), b2, voffB);
            PG8_BAR; PG8_WAIT_L(0); PG8_MMA(0, 1, At, B1); PG8_BAR;
            PG8_LDA(At, 0, 1); PG8_STAGE(PG8_SA(0, 0), a2, voffA);
            PG8_BAR; PG8_WAIT_L(0); PG8_MMA(1, 0, At, B0); PG8_BAR; PG8_SCHED;
            PG8_STAGE(PG8_SB(0, 1), b2 + hstep, voffB);
            PG8_WAIT_V(6); PG8_BAR; PG8_MMA(1, 1, At, B1); PG8_BAR;
            PG8_LDB(B0, 1, 0); PG8_SCHED; PG8_LDA(At, 1, 0); PG8_STAGE(PG8_SA(0, 1), a2 + hstep, voffA);
            PG8_WAIT_L(8); PG8_BAR; PG8_WAIT_L(0); PG8_MMA(0, 0, At, B0); PG8_BAR; PG8_SCHED;
            PG8_LDB(B1, 1, 1); PG8_STAGE(PG8_SB(1, 0), b3, voffB);
            PG8_BAR; PG8_WAIT_L(0); PG8_MMA(0, 1, At, B1); PG8_BAR;
            PG8_LDA(At, 1, 1); PG8_STAGE(PG8_SA(1, 0), a3, voffA);
            PG8_BAR; PG8_WAIT_L(0); PG8_MMA(1, 0, At, B0); PG8_BAR; PG8_SCHED;
            PG8_STAGE(PG8_SB(1, 1), b3 + hstep, voffB);
            PG8_WAIT_V(6); PG8_BAR; PG8_MMA(1, 1, At, B1); PG8_BAR;
        }
        E(acc, cur, wr, wc, fr, fq);
        if (!has_next) break;
#pragma unroll
        for (int a = 0; a < 2; ++a)
#pragma unroll
            for (int b = 0; b < 2; ++b)
#pragma unroll
                for (int m = 0; m < 4; ++m)
#pragma unroll
                    for (int n = 0; n < 2; ++n) acc[a][b][m][n] = (f32x4){0.f, 0.f, 0.f, 0.f};
        cur = nxt; cA = nA; cB = nB; ++ui;
    }
    PG8_WAIT_V(0);
    if (wr == 0) PG8_BAR;
    PG8_BAR;
#undef PG8_SA
#undef PG8_SB
#undef PG8_STAGE
#undef PG8_LDA
#undef PG8_LDB
#undef PG8_MMA
#undef PG8_WAIT_V
#undef PG8_WAIT_L
#undef PG8_BAR
#undef PG8_SCHED
}
}

enum { M_SPLIT = 0, M_VLW, M_LA, M_L2, M_G, M_PGATE, M_AGATE, M_OUT, M_PLE };
struct EpiArgs {
    int mode, pad_;
    bf16_t* o0; bf16_t* o1; bf16_t* o2; const bf16_t* i0;
    const float* f0; const float* f1; const float* f2;
    float* hout; const float* hin; const float* lse;
    float* ssq_out; const float* ssq_in; bf16_t* hb; const bf16_t* hbin;
};

__device__ __forceinline__ void store8(bf16_t* p, const f32x4& v0, const f32x4& v1) {
    u32x4 o; o[0] = cvt_pk_bf16(v0[0], v0[1]); o[1] = cvt_pk_bf16(v0[2], v0[3]); o[2] = cvt_pk_bf16(v1[0], v1[1]); o[3] = cvt_pk_bf16(v1[2], v1[3]);
    *(u32x4*)p = o;
}
__device__ __forceinline__ void load8(const bf16_t* p, f32x4& v0, f32x4& v1) {
    const u32x4 o = *(const u32x4*)p;
    v0[0] = bf_lo(o[0]); v0[1] = bf_hi(o[0]); v0[2] = bf_lo(o[1]); v0[3] = bf_hi(o[1]);
    v1[0] = bf_lo(o[2]); v1[1] = bf_hi(o[2]); v1[2] = bf_lo(o[3]); v1[3] = bf_hi(o[3]);
}

template <bool PERM_> struct Epi {
    static constexpr bool PERM = PERM_;
    EpiArgs a;
    struct Pre { float rs; float ls[6]; u32x4 q[6]; };
    template <int MODE> __device__ __forceinline__ Pre loadpre(int row, int pn, int colt) const {
        Pre p; p.rs = 1.0f;
        if constexpr (MODE == M_SPLIT || MODE == M_PGATE || MODE == M_AGATE) p.rs = a.ssq_in[row];
        if constexpr (MODE == M_G) {
#pragma unroll
            for (int bj = 0; bj < 2; ++bj) p.q[bj] = *(const u32x4*)(a.o0 + (size_t)row * DM + pn * 256 + bj * 128 + colt);
        }
        if constexpr (MODE == M_AGATE) {
#pragma unroll
            for (int bj = 0; bj < 2; ++bj) {
                const int c = pn * 256 + bj * 128 + colt, head = c >> 7;
#pragma unroll
                for (int g = 0; g < 3; ++g) {
                    p.ls[bj * 3 + g] = a.lse[((size_t)g * T_TOK + row) * 8 + head];
                    p.q[bj * 3 + g] = *(const u32x4*)(a.o0 + (size_t)g * ARR_E + (size_t)row * DM + c);
                }
            }
        }
        return p;
    }
    __device__ __forceinline__ static void unpack8(const u32x4& o, f32x4& v0, f32x4& v1) {
        v0[0] = bf_lo(o[0]); v0[1] = bf_hi(o[0]); v0[2] = bf_lo(o[1]); v0[3] = bf_hi(o[1]);
        v1[0] = bf_lo(o[2]); v1[1] = bf_hi(o[2]); v1[2] = bf_lo(o[3]); v1[3] = bf_hi(o[3]);
    }
    template <int MODE> __device__ __forceinline__ void epi8(int row, int pn, int col0, int bj, f32x4 v0, f32x4 v1, const Pre& pre) const {
        if constexpr (MODE == M_SPLIT) {
            bf16_t* dst = a.o0 + (size_t)(pn >> 2) * ARR_E + (size_t)row * DM + (pn & 3) * 256 + col0;
            store8(dst, v0, v1);
        } else if constexpr (MODE == M_VLW) {
            if (pn < 4) { store8(a.o0 + (size_t)row * DM + pn * 256 + col0, v0, v1); }
            else if (pn == 4) { if (col0 < 32) store8(a.o1 + (size_t)row * LP + 128 + col0, v0, v1); }
            else if (pn == 5) { if (col0 < 64) {
#pragma unroll
                    for (int i = 0; i < 4; ++i) { v0[i] = tanhf(v0[i]); v1[i] = tanhf(v1[i]); }
                    store8(a.o1 + (size_t)row * LP + col0, v0, v1); } }
            else { if (col0 < 64) store8(a.o1 + (size_t)row * LP + 64 + col0, v0, v1); }
        } else if constexpr (MODE == M_G) {
            bf16_t* dst = a.o0 + (size_t)row * DM + pn * 256 + col0;
            f32x4 x0, x1; unpack8(pre.q[bj], x0, x1);
#pragma unroll
            for (int i = 0; i < 4; ++i) { v0[i] = x0[i] * siluf_(v0[i]); v1[i] = x1[i] * siluf_(v1[i]); }
            store8(dst, v0, v1);
        } else if constexpr (MODE == M_PGATE) {
#pragma unroll
            for (int i = 0; i < 4; ++i) { v0[i] = sigmoidf_(v0[i]); v1[i] = sigmoidf_(v1[i]); }
            store8(a.o0 + (size_t)row * DM + pn * 256 + col0, v0, v1);
        } else if constexpr (MODE == M_AGATE) {
            const int c = pn * 256 + col0;
            const float l0 = pre.ls[bj * 3], l1 = pre.ls[bj * 3 + 1], l2 = pre.ls[bj * 3 + 2];
            const float mx = fmaxf(l0, fmaxf(l1, l2));
            float w0 = __builtin_amdgcn_exp2f(1.4426950408889634f * (l0 - mx)), w1 = __builtin_amdgcn_exp2f(1.4426950408889634f * (l1 - mx)), w2 = __builtin_amdgcn_exp2f(1.4426950408889634f * (l2 - mx));
            const float inv = __builtin_amdgcn_rcpf(w0 + w1 + w2); w0 *= inv; w1 *= inv; w2 *= inv;
            bf16_t* p0 = a.o0 + (size_t)row * DM + c;
            f32x4 x0, x1, y0, y1, z0, z1; unpack8(pre.q[bj * 3], x0, x1); unpack8(pre.q[bj * 3 + 1], y0, y1); unpack8(pre.q[bj * 3 + 2], z0, z1);
#pragma unroll
            for (int i = 0; i < 4; ++i) {
                v0[i] = (w0 * x0[i] + w1 * y0[i] + w2 * z0[i]) * siluf_(v0[i]);
                v1[i] = (w0 * x1[i] + w1 * y1[i] + w2 * z1[i]) * siluf_(v1[i]); }
            store8(p0, v0, v1);
        }
    }
    template <int MODE, int NB> __device__ __forceinline__ void runp(const f32x4 (&acc)[2][2][4][2], const pg8::Unit& u, int rowbase, int wc, int fq) const {
        const int colt = wc * 32 + 8 * fq;
#pragma unroll
        for (int b0 = 0; b0 < 8; b0 += NB) {
            Pre pre[NB];
#pragma unroll
            for (int j = 0; j < NB; ++j) pre[j] = loadpre<MODE>(rowbase + ((b0 + j) >> 2) * 128 + ((b0 + j) & 3) * 16, u.pn, colt);
#pragma unroll
            for (int j = 0; j < NB; ++j) {
                const int ai = (b0 + j) >> 2, m = (b0 + j) & 3;
                const int row = rowbase + ai * 128 + m * 16;
                float rs = 1.0f;
                if constexpr (MODE == M_SPLIT || MODE == M_PGATE || MODE == M_AGATE) rs = rsqrtf(pre[j].rs * (1.0f / 1024.0f) + 1e-6f);
#pragma unroll
                for (int bj = 0; bj < 2; ++bj) epi8<MODE>(row, u.pn, bj * 128 + colt, bj, acc[ai][bj][m][0] * rs, acc[ai][bj][m][1] * rs, pre[j]);
            }
        }
    }
    struct PreF { f32x4 hv[4]; u32x4 gg[2]; u32x4 hq[2]; };
    template <int MODE> __device__ __forceinline__ PreF loadpref(int row, int pn, int colt) const {
        PreF p;
#pragma unroll
        for (int bj = 0; bj < 2; ++bj) {
            const size_t off = (size_t)row * DM + pn * 256 + bj * 128 + colt;
            if constexpr (MODE == M_OUT) { p.hv[bj * 2] = *(const f32x4*)(a.hin + off); p.hv[bj * 2 + 1] = *(const f32x4*)(a.hin + off + 4); }
            else { p.hq[bj] = *(const u32x4*)(a.hbin + off); p.gg[bj] = *(const u32x4*)(a.i0 + off); }
        }
        return p;
    }
    template <int MODE, int NB> __device__ __forceinline__ void runf(const f32x4 (&acc)[2][2][4][2], const pg8::Unit& u, int rowbase, int wc, int fq) const {
        const int colt = wc * 32 + 8 * fq;
#pragma unroll
        for (int b0 = 0; b0 < 8; b0 += NB) {
            PreF pre[NB];
#pragma unroll
            for (int j = 0; j < NB; ++j) pre[j] = loadpref<MODE>(rowbase + ((b0 + j) >> 2) * 128 + ((b0 + j) & 3) * 16, u.pn, colt);
#pragma unroll
            for (int j = 0; j < NB; ++j) {
                const int ai = (b0 + j) >> 2, m = (b0 + j) & 3;
                const int row = rowbase + ai * 128 + m * 16;
                float ss = 0.f;
#pragma unroll
                for (int bj = 0; bj < 2; ++bj) {
                    const size_t off = (size_t)row * DM + u.pn * 256 + bj * 128 + colt;
                    const f32x4 v0 = acc[ai][bj][m][0], v1 = acc[ai][bj][m][1];
                    f32x4 o0, o1;
                    if constexpr (MODE == M_OUT) {
                        o0 = pre[j].hv[bj * 2] + v0; o1 = pre[j].hv[bj * 2 + 1] + v1;
                    } else {
                        f32x4 g0, g1, h0, h1; unpack8(pre[j].gg[bj], g0, g1); unpack8(pre[j].hq[bj], h0, h1);
                        o0 = h0 + v0 * g0; o1 = h1 + v1 * g1;
                        *(f32x4*)(a.hout + off) = o0; *(f32x4*)(a.hout + off + 4) = o1;
                    }
                    store8(a.hb + off, o0, o1);
                    ss += (o0[0] * o0[0] + o0[1] * o0[1]) + (o0[2] * o0[2] + o0[3] * o0[3]) + (o1[0] * o1[0] + o1[1] * o1[1]) + (o1[2] * o1[2] + o1[3] * o1[3]);
                }
                ss += __shfl_xor(ss, 16, 64); ss += __shfl_xor(ss, 32, 64);
                if (fq == 0) atomicAdd(a.ssq_out + row, ss);
            }
        }
    }
    __device__ __forceinline__ void operator()(const f32x4 (&acc)[2][2][4][2], const pg8::Unit& u, int wr, int wc, int fr, int fq) const {
        const int rowbase = (u.pm & 127) * 256 + wr * 64 + fr;
        if constexpr (PERM_) {
            switch (a.mode) {
            case M_SPLIT: runp<M_SPLIT, 8>(acc, u, rowbase, wc, fq); break;
            case M_VLW: runp<M_VLW, 8>(acc, u, rowbase, wc, fq); break;
            case M_G: runp<M_G, 4>(acc, u, rowbase, wc, fq); break;
            case M_PGATE: runp<M_PGATE, 8>(acc, u, rowbase, wc, fq); break;
            case M_OUT: runf<M_OUT, 2>(acc, u, rowbase, wc, fq); break;
            case M_PLE: runf<M_PLE, 2>(acc, u, rowbase, wc, fq); break;
            default: runp<M_AGATE, 1>(acc, u, rowbase, wc, fq); break;
            }
        }
    }
};

struct CJob { const float* src; bf16_t* dst; int K, N, nrows, ldd, koff; const float* ksc; };
__device__ __forceinline__ void conv_job(const CJob& j, int& cum, float* tile, int tid_, int bid_) {
    const int lane = tid_ & 63, w = tid_ >> 6, GW = gridDim.x * 8;
    float* tl = tile + w * (64 * 65);
    const int tn = j.nrows >> 6, tk = j.ldd >> 6, ntiles = tn * tk;
    const int start = ((bid_ * 8 + w) - (cum % GW) + GW) % GW;
    for (int t = start; t < ntiles; t += GW) {
        const int n0 = (t / tk) * 64, k0 = (t % tk) * 64;
        f32x4 v[16];
#pragma unroll
        for (int i = 0; i < 16; ++i) {
            const int idx = lane + 64 * i, kl = idx >> 4, n4 = (idx & 15) * 4;
            const int k = k0 + kl - j.koff, n = n0 + n4;
            v[i] = (f32x4){0.f, 0.f, 0.f, 0.f};
            if (k >= 0 && k < j.K && n < j.N) { v[i] = *(const f32x4*)(j.src + (size_t)k * j.N + n); if (j.ksc) v[i] = v[i] * j.ksc[k]; }
        }
#pragma unroll
        for (int i = 0; i < 16; ++i) {
            const int idx = lane + 64 * i, kl = idx >> 4, n4 = (idx & 15) * 4;
#pragma unroll
            for (int e = 0; e < 4; ++e) tl[kl * 65 + n4 + e] = v[i][e];
        }
        __builtin_amdgcn_wave_barrier();
#pragma unroll
        for (int jj = 0; jj < 8; ++jj) {
            const int idx = lane + 64 * jj, nl = idx >> 3, k8 = (idx & 7) * 8;
            float x[8];
#pragma unroll
            for (int e = 0; e < 8; ++e) x[e] = tl[(k8 + e) * 65 + nl];
            u32x4 o; o[0] = cvt_pk_bf16(x[0], x[1]); o[1] = cvt_pk_bf16(x[2], x[3]); o[2] = cvt_pk_bf16(x[4], x[5]); o[3] = cvt_pk_bf16(x[6], x[7]);
            *(u32x4*)(j.dst + (size_t)(n0 + nl) * j.ldd + k0 + k8) = o;
        }
        __builtin_amdgcn_wave_barrier();
    }
    cum += ntiles;
}
__device__ __forceinline__ void convert_phase(PP P, float* tile, int tid_, int bid_) {
    bf16_t* W = (bf16_t*)(P->ws + WS_W);
    int cum = 0;
    { float* ssq = (float*)(P->ws + WS_SSQ); for (int i = bid_ * 512 + tid_; i < 9 * T_TOK; i += gridDim.x * 512) ssq[i] = (i < 8 * T_TOK) ? 0.f : 1023.999f; }
    for (int l = 0; l < 2; ++l) {
        bf16_t* base = W + l * RW_STRIDE;
        const float* rkvg = P->in[4] + (size_t)l * 4 * 1048576;
        CJob j;
        j = {rkvg, base + RW_WRK, 1024, 1024, 1024, 1024, 0, nullptr}; conv_job(j, cum, tile, tid_, bid_);
        j = {rkvg + 1048576, base + RW_WRK + 1048576, 1024, 1024, 1024, 1024, 0, nullptr}; conv_job(j, cum, tile, tid_, bid_);
        j = {rkvg + 2 * 1048576, base + RW_WVW, 1024, 1024, 1024, 1024, 0, nullptr}; conv_job(j, cum, tile, tid_, bid_);
        j = {P->in[12], base + RW_WVW + 1048576, 1024, l == 0 ? 0 : 32, 256, 1024, 0, nullptr}; conv_job(j, cum, tile, tid_, bid_);
        j = {P->in[6] + (size_t)l * 65536, base + RW_WVW + 1048576 + 262144, 1024, 64, 256, 1024, 0, nullptr}; conv_job(j, cum, tile, tid_, bid_);
        j = {P->in[9] + (size_t)l * 65536, base + RW_WA1, 1024, 64, 256, 1024, 0, nullptr}; conv_job(j, cum, tile, tid_, bid_);
        j = {P->in[7] + (size_t)l * 65536, base + RW_W2C, 64, 1024, 1024, 256, 0, nullptr}; conv_job(j, cum, tile, tid_, bid_);
        j = {P->in[10] + (size_t)l * 65536, base + RW_W2C + 262144, 64, 1024, 1024, 256, 64, nullptr}; conv_job(j, cum, tile, tid_, bid_);
        j = {P->in[13], base + RW_W2C + 524288, 32, l == 0 ? 0 : 1024, 1024, 256, 128, nullptr}; conv_job(j, cum, tile, tid_, bid_);
        j = {rkvg + 3 * 1048576, base + RW_WG, 1024, 1024, 1024, 1024, 0, nullptr}; conv_job(j, cum, tile, tid_, bid_);
        j = {P->in[19] + (size_t)l * 1048576, base + RW_WO, 1024, 1024, 1024, 1024, 0, nullptr}; conv_job(j, cum, tile, tid_, bid_);
    }
    for (int i = 0; i < 4; ++i) {
        bf16_t* base = W + PLE_BASE + i * PLE_STRIDE;
        CJob j;
        j = {P->in[27] + (size_t)i * 1048576, base, 1024, 1024, 1024, 1024, 0, P->in[26] + i * 1024}; conv_job(j, cum, tile, tid_, bid_);
        j = {P->in[25] + (size_t)i * 262144, base + PLE_WP, 256, 1024, 1024, 256, 0, nullptr}; conv_job(j, cum, tile, tid_, bid_);
    }
    { CJob j = {P->in[21], W + KV_BASE, 1024, 2048, 2048, 1024, 0, nullptr}; conv_job(j, cum, tile, tid_, bid_); }
    for (int q = 0; q < 2; ++q) {
        bf16_t* base = W + ATT_BASE + q * ATT_STRIDE;
        CJob j;
        j = {P->in[23] + (size_t)q * 4194304, base, 1024, 4096, 4096, 1024, 0, P->in[22] + q * 1024}; conv_job(j, cum, tile, tid_, bid_);
        j = {P->in[24] + (size_t)q * 1048576, base + ATT_WO, 1024, 1024, 1024, 1024, 0, nullptr}; conv_job(j, cum, tile, tid_, bid_);
    }
}

__device__ __forceinline__ void pconv(PP P, int layer, bool zeroL, int tid_, int bid_) {
    const float* src = P->in[1] + (size_t)layer * T_TOK * 256;
    bf16_t* dst = (bf16_t*)(P->ws + WS_P);
    const size_t n8 = (size_t)T_TOK * 256 / 8, stride = (size_t)gridDim.x * 512;
    if (layer >= 0) for (size_t i = (size_t)bid_ * 512 + tid_; i < n8; i += 4 * stride) {
        f32x4 av[4], bv[4];
#pragma unroll
        for (int u = 0; u < 4; ++u) { const size_t ii = i + u * stride; if (ii < n8) { av[u] = *(const f32x4*)(src + ii * 8); bv[u] = *(const f32x4*)(src + ii * 8 + 4); } }
#pragma unroll
        for (int u = 0; u < 4; ++u) { const size_t ii = i + u * stride; if (ii < n8) store8(dst + ii * 8, av[u], bv[u]); }
    }
    if (zeroL) {
        bf16_t* L = (bf16_t*)(P->ws + WS_L);
        const size_t nz = (size_t)T_TOK * 16;
        for (size_t i = (size_t)bid_ * 512 + tid_; i < nz; i += stride) {
            const size_t row = i >> 4, cc = i & 15;
            *(u32x4*)(L + row * 256 + 128 + cc * 8) = (u32x4){0u, 0u, 0u, 0u};
        }
    }
}

__device__ __forceinline__ void load_row(const float* p, int lane, f32x4 (&r)[4]) {
#pragma unroll
    for (int i = 0; i < 4; ++i) r[i] = *(const f32x4*)(p + lane * 4 + 256 * i);
}
__device__ __forceinline__ float row_rstd(const f32x4 (&r)[4]) {
    float ss = 0.f;
#pragma unroll
    for (int i = 0; i < 4; ++i) ss += r[i][0] * r[i][0] + r[i][1] * r[i][1] + r[i][2] * r[i][2] + r[i][3] * r[i][3];
    ss = wave_sum(ss);
    return rsqrtf(ss * (1.0f / 1024.0f) + 1e-6f);
}
__device__ __forceinline__ void prep_shift(const float* hin, const float* g, const float* mu0, const float* mu1, const float* mu2, bf16_t* X0, bf16_t* X1, bf16_t* X2, int tid_, int bid_,
                                           const bf16_t* Yr, const bf16_t* Ad, const float* gng, const float* gnb, bf16_t* Yo) {
    const int lane = tid_ & 63, gw = bid_ * 8 + (tid_ >> 6);
    const int per = T_TOK / (gridDim.x * 8);
    f32x4 gv[4], m0[4], m1[4], m2[4], prev[4], row[4];
    load_row(g, lane, gv); load_row(mu0, lane, m0);
    if (X1) load_row(mu1, lane, m1);
    if (X2) load_row(mu2, lane, m2);
    const int t0 = gw * per;
    if ((t0 & (SEQ - 1)) == 0) {
#pragma unroll
        for (int i = 0; i < 4; ++i) prev[i] = (f32x4){0.f, 0.f, 0.f, 0.f};
    } else {
        load_row(hin + (size_t)(t0 - 1) * DM, lane, row);
        const float rs = row_rstd(row);
#pragma unroll
        for (int i = 0; i < 4; ++i) prev[i] = row[i] * rs * gv[i];
    }
    f32x4 rown[4];
    load_row(hin + (size_t)t0 * DM, lane, rown);
    f32x4 gng4[4], gnb4[4]; u32x2 yqn[4], aqn[4];
    if (Yo) {
        load_row(gng, lane, gng4); load_row(gnb, lane, gnb4);
#pragma unroll
        for (int i = 0; i < 4; ++i) { const size_t off = (size_t)t0 * DM + lane * 4 + 256 * i; yqn[i] = *(const u32x2*)(Yr + off); aqn[i] = *(const u32x2*)(Ad + off); }
    }
    for (int k = 0; k < per; ++k) {
        const int t = t0 + k;
#pragma unroll
        for (int i = 0; i < 4; ++i) row[i] = rown[i];
        load_row(hin + (size_t)(k + 1 < per ? t + 1 : t) * DM, lane, rown);
        u32x2 yqc[4], aqc[4];
        if (Yo) {
#pragma unroll
            for (int i = 0; i < 4; ++i) { yqc[i] = yqn[i]; aqc[i] = aqn[i];
                const size_t off = (size_t)(k + 1 < per ? t + 1 : t) * DM + lane * 4 + 256 * i; yqn[i] = *(const u32x2*)(Yr + off); aqn[i] = *(const u32x2*)(Ad + off); }
        }
        const float rs = row_rstd(row);
#pragma unroll
        for (int i = 0; i < 4; ++i) {
            const f32x4 xn = row[i] * rs * gv[i];
            const f32x4 xx = prev[i] - xn;
            const f32x4 a = xn + xx * m0[i];
            u32x2 o; o[0] = cvt_pk_bf16(a[0], a[1]); o[1] = cvt_pk_bf16(a[2], a[3]);
            *(u32x2*)(X0 + (size_t)t * DM + lane * 4 + 256 * i) = o;
            if (X1) {
                const f32x4 b = xn + xx * m1[i];
                u32x2 o2; o2[0] = cvt_pk_bf16(b[0], b[1]); o2[1] = cvt_pk_bf16(b[2], b[3]);
                *(u32x2*)(X1 + (size_t)t * DM + lane * 4 + 256 * i) = o2;
            }
            if (X2) {
                const f32x4 b = xn + xx * m2[i];
                u32x2 o2; o2[0] = cvt_pk_bf16(b[0], b[1]); o2[1] = cvt_pk_bf16(b[2], b[3]);
                *(u32x2*)(X2 + (size_t)t * DM + lane * 4 + 256 * i) = o2;
            }
            prev[i] = xn;
        }
        if (Yo) {
#pragma unroll
            for (int i = 0; i < 4; ++i) {
                const size_t off = (size_t)t * DM + lane * 4 + 256 * i;
                const u32x2 yq = yqc[i], aq = aqc[i];
                const f32x4 y4 = {bf_lo(yq[0]), bf_hi(yq[0]), bf_lo(yq[1]), bf_hi(yq[1])};
                const f32x4 a4 = {bf_lo(aq[0]), bf_hi(aq[0]), bf_lo(aq[1]), bf_hi(aq[1])};
                float sm = (y4[0] + y4[1]) + (y4[2] + y4[3]);
                sm = sum16d(sm);
                const float mean = sm * (1.0f / 64.0f);
                const f32x4 yc = y4 - mean;
                float vs = yc[0] * yc[0] + yc[1] * yc[1] + yc[2] * yc[2] + yc[3] * yc[3];
                vs = sum16d(vs);
                const float r2 = rsqrtf(vs * (1.0f / 64.0f) + 64e-5f);
                const f32x4 ov = yc * r2 * gng4[i] + gnb4[i] + a4;
                u32x2 o; o[0] = cvt_pk_bf16(ov[0], ov[1]); o[1] = cvt_pk_bf16(ov[2], ov[3]);
                *(u32x2*)(Yo + off) = o;
            }
        }
    }
}
__device__ __forceinline__ void prep_plain(const float* hin, const float* g, bf16_t* X0, int tid_, int bid_) {
    const int lane = tid_ & 63, gw = bid_ * 8 + (tid_ >> 6);
    const int per = T_TOK / (gridDim.x * 8);
    f32x4 gv[4], row[4];
    load_row(g, lane, gv);
    for (int k = 0; k < per; ++k) {
        const int t = gw * per + k;
        load_row(hin + (size_t)t * DM, lane, row);
        const float rs = row_rstd(row);
#pragma unroll
        for (int i = 0; i < 4; ++i) {
            const f32x4 a = row[i] * rs * gv[i];
            u32x2 o; o[0] = cvt_pk_bf16(a[0], a[1]); o[1] = cvt_pk_bf16(a[2], a[3]);
            *(u32x2*)(X0 + (size_t)t * DM + lane * 4 + 256 * i) = o;
        }
    }
}
__device__ __forceinline__ void final_norm(float* h, const float* g, const float* ssq, int tid_, int bid_) {
    const int lane = tid_ & 63, gw = bid_ * 8 + (tid_ >> 6);
    const int per = T_TOK / (gridDim.x * 8);
    f32x4 gv[4], r0[4], r1[4], r2[4];
    load_row(g, lane, gv);
    const int t0 = gw * per;
    load_row(h + (size_t)t0 * DM, lane, r0); float s0 = ssq[t0];
    load_row(h + (size_t)(t0 + 1) * DM, lane, r1); float s1 = ssq[t0 + 1];
    for (int k = 0; k < per; ++k) {
        const int t = t0 + k;
        const int tn = (k + 2 < per) ? t + 2 : t;
        load_row(h + (size_t)tn * DM, lane, r2); const float s2 = ssq[tn];
        const float rs = rsqrtf(s0 * (1.0f / 1024.0f) + 1e-6f);
#pragma unroll
        for (int i = 0; i < 4; ++i) *(f32x4*)(h + (size_t)t * DM + lane * 4 + 256 * i) = r0[i] * rs * gv[i];
#pragma unroll
        for (int i = 0; i < 4; ++i) { r0[i] = r1[i]; r1[i] = r2[i]; }
        s0 = s1; s1 = s2;
    }
}

constexpr int TC = 32;
typedef float f32x2 __attribute__((ext_vector_type(2)));
struct StepOps { f32x4 k0, k1, k2, k3, wa, wb, ba, bb, xa, xb; };
constexpr int VTP = TC + 4;
constexpr int SB_KR = 0, SB_WW = TC * 128, SB_BN = SB_WW + TC * 64, SB_KX = SB_BN + TC * 64, SB_VV = SB_KX + TC * 64, SB_ADD = SB_VV + 32 * VTP, SB_SC = SB_ADD + TC * 32, SB_SIZE = SB_SC + 2 * TC;
__device__ __forceinline__ void scan_phase(PP P, int l, float* L, int tid_, int bid_, const bf16_t* Lo) {
    float* s_y = L + 2 * SB_SIZE;
    unsigned char* s_w2 = (unsigned char*)(s_y + 2 * TC * 32);
    const int pair = bid_ >> 1, half = bid_ & 1;
    const int b = pair >> 4, h = pair & 15;
    const int tid = tid_, lane = tid & 63, w = tid >> 6, l15 = lane & 15, quad = lane >> 4;
    const bool prod = (w >= 4);
    const int ptid = tid & 255;
    const int tt = ptid >> 4, cgp = ptid & 15, ch = h * 64 + 4 * cgp;
    const bool own = (cgp >> 3) == half;
    bf16_t* arr = (bf16_t*)(P->ws + WS_ARR);
    const bf16_t* R = arr + 2 * ARR_E; const bf16_t* Kp = arr + 3 * ARR_E;
    const bf16_t* V = arr + (size_t)(l == 0 ? 4 : 5) * ARR_E; const bf16_t* Vf = arr + 4 * ARR_E;
    bf16_t* Yr = arr + 5 * ARR_E; bf16_t* Ad = arr + ARR_E;
    const f32x4 pkk = *(const f32x4*)(P->in[14] + l * 1024 + ch), pka = *(const f32x4*)(P->in[15] + l * 1024 + ch), prk = *(const f32x4*)(P->in[16] + l * 1024 + ch);
    const size_t rowbase = (size_t)b * SEQ;
    const int mt = w & 1, ntb = 2 * ((w >> 1) & 1);
    const bf16_t* W2 = (const bf16_t*)(P->ws + WS_W) + l * RW_STRIDE + RW_W2C;
    {
        const int rr = tid >> 3, pc = tid & 7;
        *(u32x4*)(s_w2 + rr * 144 + pc * 16) = *(const u32x4*)(W2 + (size_t)(h * 64 + rr) * 256 + pc * 8);
        *(u32x4*)(s_w2 + 9216 + rr * 144 + pc * 16) = *(const u32x4*)(W2 + (size_t)(1024 + h * 64 + rr) * 256 + 64 + pc * 8);
        if (tid < 256) { const int r2 = tid >> 2, p2 = tid & 3; *(u32x4*)(s_w2 + 18432 + r2 * 80 + p2 * 16) = *(const u32x4*)(W2 + (size_t)(2048 + h * 64 + r2) * 256 + 128 + p2 * 8); }
    }
    float w0c[2], a0c[2], v0c[2];
#pragma unroll
    for (int n2 = 0; n2 < 2; ++n2) {
        const int chn = h * 64 + 16 * (ntb + n2) + l15;
        w0c[n2] = P->in[5][l * 1024 + chn]; a0c[n2] = P->in[8][l * 1024 + chn]; v0c[n2] = P->in[11][chn];
    }
    u32x2 qr[2], qk[2], qv[2], qf[2];
    bf16x8 lw[2], la[2], lv;
    auto issue = [&](int c) {
#pragma unroll
        for (int u = 0; u < 2; ++u) {
            const size_t off = (rowbase + (size_t)c * TC + tt + 16 * u) * DM + ch;
            qr[u] = *(const u32x2*)(R + off); qk[u] = *(const u32x2*)(Kp + off);
            qv[u] = (u32x2){0u, 0u}; qf[u] = (u32x2){0u, 0u};
            if (own) { qv[u] = *(const u32x2*)(V + off); if (l) qf[u] = *(const u32x2*)(Vf + off); }
        }
        const bf16_t* lrow = Lo + (rowbase + (size_t)c * TC + 16 * mt + l15) * LP;
        lw[0] = *(const bf16x8*)(lrow + quad * 8); lw[1] = *(const bf16x8*)(lrow + 32 + quad * 8);
        la[0] = *(const bf16x8*)(lrow + 64 + quad * 8); la[1] = *(const bf16x8*)(lrow + 96 + quad * 8);
        lv = *(const bf16x8*)(lrow + 128 + quad * 8);
    };
    auto lora2 = [&](float* sb) {
#pragma unroll
        for (int n2 = 0; n2 < 2; ++n2) {
            f32x4 aw = {0.f, 0.f, 0.f, 0.f}, aa = {0.f, 0.f, 0.f, 0.f}, av = {0.f, 0.f, 0.f, 0.f};
            const int chl = 16 * (ntb + n2) + l15;
            const bf16x8 bw0 = *(const bf16x8*)(s_w2 + chl * 144 + quad * 16), bw1 = *(const bf16x8*)(s_w2 + chl * 144 + 64 + quad * 16);
            const bf16x8 ba0 = *(const bf16x8*)(s_w2 + 9216 + chl * 144 + quad * 16), ba1 = *(const bf16x8*)(s_w2 + 9216 + chl * 144 + 64 + quad * 16);
            aw = __builtin_amdgcn_mfma_f32_16x16x32_bf16(lw[0], bw0, aw, 0, 0, 0);
            aw = __builtin_amdgcn_mfma_f32_16x16x32_bf16(lw[1], bw1, aw, 0, 0, 0);
            aa = __builtin_amdgcn_mfma_f32_16x16x32_bf16(la[0], ba0, aa, 0, 0, 0);
            aa = __builtin_amdgcn_mfma_f32_16x16x32_bf16(la[1], ba1, aa, 0, 0, 0);
            if (l) { const bf16x8 bv0 = *(const bf16x8*)(s_w2 + 18432 + chl * 80 + quad * 16); av = __builtin_amdgcn_mfma_f32_16x16x32_bf16(lv, bv0, av, 0, 0, 0); }
#pragma unroll
            for (int e = 0; e < 4; ++e) {
                const int o = (16 * mt + 4 * quad + e) * 64 + chl;
                sb[SB_WW + o] = 0.60653066f * sigmoidf_(w0c[n2] + aw[e]);
                sb[SB_BN + o] = sigmoidf_(a0c[n2] + aa[e]);
                if (l) sb[SB_KX + o] = sigmoidf_(v0c[n2] + av[e]);
            }
        }
    };
    auto prep = [&](float* sb) {
#pragma unroll
        for (int u = 0; u < 2; ++u) {
            const int tk = tt + 16 * u;
            const int o = tk * 64 + 4 * cgp;
            f32x4 r4 = {bf_lo(qr[u][0]), bf_hi(qr[u][0]), bf_lo(qr[u][1]), bf_hi(qr[u][1])};
            f32x4 k4 = {bf_lo(qk[u][0]), bf_hi(qk[u][0]), bf_lo(qk[u][1]), bf_hi(qk[u][1])};
            f32x4 v4 = {bf_lo(qv[u][0]), bf_hi(qv[u][0]), bf_lo(qv[u][1]), bf_hi(qv[u][1])};
            const f32x4 e4 = *(const f32x4*)(sb + SB_WW + o), a4 = *(const f32x4*)(sb + SB_BN + o);
            if (l) {
                const f32x4 vf = {bf_lo(qf[u][0]), bf_hi(qf[u][0]), bf_lo(qf[u][1]), bf_hi(qf[u][1])};
                const f32x4 gm = *(const f32x4*)(sb + SB_KX + o);
                v4 = v4 + (vf - v4) * gm;
            }
            f32x4 w4, kkv, kx, bn, wrv;
            float ss = 0.f, br = 0.f, kr = 0.f, bo = 0.f;
#pragma unroll
            for (int i = 0; i < 4; ++i) { w4[i] = __builtin_amdgcn_exp2f(-1.4426950408889634f * e4[i]); kkv[i] = k4[i] * pkk[i]; ss += kkv[i] * kkv[i]; kx[i] = k4[i] * (1.0f + (a4[i] - 1.0f) * pka[i]); }
            ss = sum16d(ss);
            const float inv = __builtin_amdgcn_rsqf(fmaxf(ss, 1e-24f));
#pragma unroll
            for (int i = 0; i < 4; ++i) { kkv[i] *= inv; bn[i] = -(kkv[i] * a4[i]); wrv[i] = w4[i] * r4[i]; br += bn[i] * r4[i]; kr += kx[i] * r4[i]; bo += r4[i] * kx[i] * prk[i]; }
            br = sum16d(br); kr = sum16d(kr); bo = sum16d(bo);
            { float* kr = sb + SB_KR + tk * 128 + (cgp & 1) * 64 + (cgp >> 1) * 4;
              *(f32x4*)(kr) = (f32x4){kkv[0], wrv[0], kkv[1], wrv[1]};
              *(f32x4*)(kr + 32) = (f32x4){kkv[2], wrv[2], kkv[3], wrv[3]}; }
            *(f32x4*)(sb + SB_BN + o) = bn; *(f32x4*)(sb + SB_WW + o) = w4; *(f32x4*)(sb + SB_KX + o) = kx;
            if (own) { const int o2 = tk * 32 + 4 * (cgp & 7); *(f32x4*)(sb + SB_ADD + o2) = v4 * bo;
#pragma unroll
                for (int i = 0; i < 4; ++i) sb[SB_VV + (4 * (cgp & 7) + i) * VTP + tk] = v4[i]; }
            if (cgp == 0) { sb[SB_SC + tk * 2] = br; sb[SB_SC + tk * 2 + 1] = kr; }
        }
    };
    auto epilogue = [&](int c) {
        const float* sb = L + (c & 1) * SB_SIZE;
        const int tk = ptid >> 3, i4 = 4 * (ptid & 7);
        const f32x4 y4 = *(const f32x4*)(s_y + (c & 1) * TC * 32 + tk * 32 + i4), a4 = *(const f32x4*)(sb + SB_ADD + tk * 32 + i4);
        const size_t off = (rowbase + (size_t)c * TC + tk) * DM + h * 64 + 32 * half + i4;
        u32x2 oy, oa; oy[0] = cvt_pk_bf16(y4[0], y4[1]); oy[1] = cvt_pk_bf16(y4[2], y4[3]); oa[0] = cvt_pk_bf16(a4[0], a4[1]); oa[1] = cvt_pk_bf16(a4[2], a4[3]);
        *(u32x2*)(Yr + off) = oy;
        *(u32x2*)(Ad + off) = oa;
    };
    const int rl = 8 * (w & 3) + (lane >> 3), jc = lane & 7;
    f32x4 st = {0.f, 0.f, 0.f, 0.f}, su = {0.f, 0.f, 0.f, 0.f};
    auto steps16 = [&](const float* sb, float* sy, int t0) {
        auto ldstep = [&](int t) {
            StepOps s;
            s.k0 = *(const f32x4*)(sb + SB_KR + t * 128 + 4 * jc); s.k1 = *(const f32x4*)(sb + SB_KR + t * 128 + 32 + 4 * jc);
            s.k2 = *(const f32x4*)(sb + SB_KR + t * 128 + 64 + 4 * jc); s.k3 = *(const f32x4*)(sb + SB_KR + t * 128 + 96 + 4 * jc);
            s.wa = *(const f32x4*)(sb + SB_WW + t * 64 + 8 * jc); s.wb = *(const f32x4*)(sb + SB_WW + t * 64 + 8 * jc + 4);
            s.ba = *(const f32x4*)(sb + SB_BN + t * 64 + 8 * jc); s.bb = *(const f32x4*)(sb + SB_BN + t * 64 + 8 * jc + 4);
            s.xa = *(const f32x4*)(sb + SB_KX + t * 64 + 8 * jc); s.xb = *(const f32x4*)(sb + SB_KX + t * 64 + 8 * jc + 4);
            return s;
        };
        StepOps cur = ldstep(t0);
        for (int tb = t0; tb < t0 + 16; tb += 8) {
            const f32x4 va = *(const f32x4*)(sb + SB_VV + rl * VTP + tb), vb = *(const f32x4*)(sb + SB_VV + rl * VTP + tb + 4);
            const f32x4 c0 = *(const f32x4*)(sb + SB_SC + 2 * tb), c1 = *(const f32x4*)(sb + SB_SC + 2 * tb + 4), c2 = *(const f32x4*)(sb + SB_SC + 2 * tb + 8), c3 = *(const f32x4*)(sb + SB_SC + 2 * tb + 12);
            const float vis[8] = {va[0], va[1], va[2], va[3], vb[0], vb[1], vb[2], vb[3]};
            const float brs[8] = {c0[0], c0[2], c1[0], c1[2], c2[0], c2[2], c3[0], c3[2]};
            const float krs[8] = {c0[1], c0[3], c1[1], c1[3], c2[1], c2[3], c3[1], c3[3]};
            float yacc = 0.f;
#pragma unroll
            for (int u = 0; u < 8; ++u) {
                const int t = tb + u;
                const StepOps nxt = ldstep(t + 1 < TC ? t + 1 : TC - 1);
                const float vi = vis[u];
                f32x2 p = (f32x2){st[0], st[0]} * (f32x2){cur.k0[0], cur.k0[1]};
                f32x2 q = (f32x2){su[0], su[0]} * (f32x2){cur.k2[0], cur.k2[1]};
                p = (f32x2){st[1], st[1]} * (f32x2){cur.k0[2], cur.k0[3]} + p;
                q = (f32x2){su[1], su[1]} * (f32x2){cur.k2[2], cur.k2[3]} + q;
                p = (f32x2){st[2], st[2]} * (f32x2){cur.k1[0], cur.k1[1]} + p;
                q = (f32x2){su[2], su[2]} * (f32x2){cur.k3[0], cur.k3[1]} + q;
                p = (f32x2){st[3], st[3]} * (f32x2){cur.k1[2], cur.k1[3]} + p;
                q = (f32x2){su[3], su[3]} * (f32x2){cur.k3[2], cur.k3[3]} + q;
                p = p + q;
                float p1 = p[0], p2 = p[1];
                p1 += dpp_xor1(p1); p2 += dpp_xor1(p2);
                p1 += dpp_xor2(p1); p2 += dpp_xor2(p2);
                p1 += dpp_hmir(p1); p2 += dpp_hmir(p2);
                const float y = p2 + p1 * brs[u] + vi * krs[u];
                yacc = (jc == u) ? y : yacc;
                st = st * cur.wa + (cur.ba * p1 + cur.xa * vi);
                su = su * cur.wb + (cur.bb * p1 + cur.xb * vi);
                cur = nxt;
            }
            sy[(tb + jc) * 32 + rl] = yacc;
        }
    };
    constexpr int NCH = SEQ / TC;
    if (prod) issue(0);
    __syncthreads();
    if (prod) lora2(L);
    __syncthreads();
    if (prod) { prep(L); if (1 < NCH) issue(1); }
    __syncthreads();
    for (int c = 0; c < NCH; ++c) {
        float* sb = L + (c & 1) * SB_SIZE;
        float* sn = L + ((c + 1) & 1) * SB_SIZE;
        if (!prod) { __builtin_amdgcn_s_setprio(3); steps16(sb, s_y + (c & 1) * TC * 32, 0); __builtin_amdgcn_s_setprio(0); }
        else { if (c > 0) epilogue(c - 1); if (c + 1 < NCH) lora2(sn); }
        __syncthreads();
        if (!prod) { __builtin_amdgcn_s_setprio(3); steps16(sb, s_y + (c & 1) * TC * 32, 16); __builtin_amdgcn_s_setprio(0); }
        else if (c + 1 < NCH) { prep(sn); if (c + 2 < NCH) issue(c + 2); }
        __syncthreads();
    }
    if (prod) epilogue(NCH - 1);
}

constexpr int KPITCH = 272, VB_OFF = 256 * KPITCH;
__device__ __forceinline__ void attn_phase(PP P, unsigned char* lds, int tid_, int bid_, bool dry) {
    const int tid = tid_, lane = tid & 63, w = tid >> 6, l15 = lane & 15, quad = lane >> 4;
    bf16_t* arr = (bf16_t*)(P->ws + WS_ARR);
    bf16_t* Q = arr + ARR_E; const bf16_t* Kc = arr + 4 * ARR_E; const bf16_t* Vc = arr + 5 * ARR_E;
    float* LSE = (float*)(P->ws + WS_LSE);
    const float LOG2E = 1.4426950408889634f;
    const int bh = bid_ >> 2, sub = bid_ & 3, b = bh >> 3, h = bh & 7;
    const size_t rowb = (size_t)b * SEQ;
    const unsigned ldsbase = (unsigned)(size_t)(LAS unsigned char*)lds;
    const float sc = 0.08838834764831845f * LOG2E;
    const float sl = exp2f(-(float)(h + 1)) * LOG2E;
    u32x4 kpre[4], vpre[4];
    auto decode = [&](int s, int& g, int& r, int& c, bool& first, bool& last) {
        if (s < 8) { g = 0; r = 0; c = sub * 8 + s; first = (s == 0); last = (s == 7); }
        else if (s < 16) { g = 1; r = sub; c = s - 8; first = (s == 8); last = (s == 15); }
        else { g = 2; r = sub * 4 + ((s - 16) >> 1); c = (s - 16) & 1; first = (c == 0); last = (c == 1); }
    };
    const int qi = 16 * w + l15;
    auto qptr = [&](int g, int r, int c) -> bf16_t* {
        const int d = 1 << (2 * g);
        const size_t qrow = rowb + (size_t)(c * 128 + qi) * d + r;
        return Q + (size_t)g * ARR_E + qrow * DM + h * 128;
    };
    bf16x8 qn[4];
    {   int g, r, c; bool f, l; decode(0, g, r, c, f, l);
        const bf16_t* qp0 = qptr(g, r, c);
#pragma unroll
        for (int ks = 0; ks < 4; ++ks) qn[ks] = *(const bf16x8*)(qp0 + ks * 32 + quad * 8);
    }
    const int wodd = w & 1, pb = w & ~1;
    for (int s = 0; s < 24; ++s) {
        int g, r, c; bool first, last;
        decode(s, g, r, c, first, last);
        const int d = 1 << (2 * g);
        auto gload2 = [&](int blk, int dd, int rr, u32x4 (&kk)[4], u32x4 (&vv)[4]) {
#pragma unroll
            for (int i = 0; i < 4; ++i) {
                const int idx = tid + 512 * i, j = idx >> 4, cc = idx & 15;
                if (blk >= 0) {
                    const size_t off = (rowb + (size_t)(blk * 128 + j) * dd + rr) * DM + h * 128 + cc * 8;
                    kk[i] = *(const u32x4*)(Kc + off); vv[i] = *(const u32x4*)(Vc + off);
                } else { kk[i] = (u32x4){0u, 0u, 0u, 0u}; vv[i] = (u32x4){0u, 0u, 0u, 0u}; }
            }
        };
        auto gload = [&](int blk, u32x4 (&kk)[4], u32x4 (&vv)[4]) { gload2(blk, d, r, kk, vv); };
        auto lstore = [&](int slot, const u32x4 (&kk)[4], const u32x4 (&vv)[4]) {
#pragma unroll
            for (int i = 0; i < 4; ++i) {
                const int idx = tid + 512 * i, j = idx >> 4, cc = idx & 15;
                *(u32x4*)(lds + (slot * 128 + j) * KPITCH + cc * 16) = kk[i];
                *(u32x4*)(lds + VB_OFF + (slot * 128 + j) * KPITCH + cc * 16) = vv[i];
            }
        };
        if (first) {
            if (s == 0) gload(c, kpre, vpre);
            __syncthreads();
            lstore(c & 1, kpre, vpre);
            gload(c - 1, kpre, vpre); lstore((c - 1) & 1, kpre, vpre);
            __syncthreads();
        }
        bf16_t* qp = qptr(g, r, c);
        const size_t qrow = rowb + (size_t)(c * 128 + qi) * d + r;
        bf16x8 qf[4];
#pragma unroll
        for (int ks = 0; ks < 4; ++ks) qf[ks] = qn[ks];
        if (s + 1 < 24) {
            int g2, r2, c2; bool f2, l2; decode(s + 1, g2, r2, c2, f2, l2);
            const bf16_t* qp2 = qptr(g2, r2, c2);
#pragma unroll
            for (int ks = 0; ks < 4; ++ks) qn[ks] = *(const bf16x8*)(qp2 + ks * 32 + quad * 8);
        }
        if (!last) gload(c + 1, kpre, vpre);
        else if (s + 1 < 24) {
            int g2, r2, c2; bool f2, l2; decode(s + 1, g2, r2, c2, f2, l2);
            gload2(c2, 1 << (2 * g2), r2, kpre, vpre);
        }
        const int xr = (c & 1) ? 0 : 8;
        f32x4 sv[10];
#pragma unroll
        for (int tt = 0; tt < 10; ++tt) {
            f32x4 acc = {0.f, 0.f, 0.f, 0.f};
            const unsigned char* kb = lds + (16 * ((pb + tt) ^ xr) + l15) * KPITCH + quad * 16;
            const bool outside = (tt == 0) ? (wodd != 0) : ((tt == 9) ? (wodd == 0) : false);
            if (!outside) {
#pragma unroll
                for (int ks = 0; ks < 4; ++ks) {
                    const bf16x8 a = *(const bf16x8*)(kb + ks * 64);
                    acc = __builtin_amdgcn_mfma_f32_16x16x32_bf16(a, qf[ks], acc, 0, 0, 0);
                }
            }
            sv[tt] = acc;
        }
        const float b0 = -sl * (float)(128 + l15 + 16 * wodd - 4 * quad);
        const float sl16 = 16.0f * sl;
        float mx = -INFINITY;
#pragma unroll
        for (int tt = 0; tt < 10; ++tt) {
            const float bt = b0 + sl16 * (float)tt;
            const bool tile_ok = (c > 0) || (pb + tt >= 8);
#pragma unroll
            for (int e = 0; e < 4; ++e) {
                float sx = sv[tt][e] * sc + (bt + sl * (float)e);
                if (tt < 2 || tt > 7) {
                    const int delta = 128 + l15 + 16 * wodd - 16 * tt - 4 * quad - e;
                    sx = ((delta >= 0) && (delta <= 128) && tile_ok) ? sx : -INFINITY;
                } else {
                    sx = tile_ok ? sx : -INFINITY;
                }
                sv[tt][e] = sx; mx = fmaxf(mx, sx);
            }
        }
        mx = fmaxf(mx, __shfl_xor(mx, 16, 64)); mx = fmaxf(mx, __shfl_xor(mx, 32, 64));
        float lsum = 0.f;
#pragma unroll
        for (int tt = 0; tt < 10; ++tt)
#pragma unroll
            for (int e = 0; e < 4; ++e) { const float p = __builtin_amdgcn_exp2f(sv[tt][e] - mx); sv[tt][e] = p; lsum += p; }
        lsum += __shfl_xor(lsum, 16, 64); lsum += __shfl_xor(lsum, 32, 64);
        bf16x8 pf[5];
#pragma unroll
        for (int pp = 0; pp < 5; ++pp) {
            u32x4 o; o[0] = cvt_pk_bf16(sv[2 * pp][0], sv[2 * pp][1]); o[1] = cvt_pk_bf16(sv[2 * pp][2], sv[2 * pp][3]);
            o[2] = cvt_pk_bf16(sv[2 * pp + 1][0], sv[2 * pp + 1][1]); o[3] = cvt_pk_bf16(sv[2 * pp + 1][2], sv[2 * pp + 1][3]);
            pf[pp] = __builtin_bit_cast(bf16x8, o);
        }
        const float invl = __builtin_amdgcn_rcpf(lsum);
        unsigned va[5];
#pragma unroll
        for (int pp = 0; pp < 5; ++pp) va[pp] = ldsbase + VB_OFF + (16 * ((pb + 2 * pp) ^ xr) + 4 * quad + (l15 >> 2)) * KPITCH + 16 * (l15 & 3);
#define TR_ISSUE(T, DT) asm volatile( \
                "ds_read_b64_tr_b16 %0, %10 offset:%15\n\t" "ds_read_b64_tr_b16 %1, %10 offset:%16\n\t" \
                "ds_read_b64_tr_b16 %2, %11 offset:%15\n\t" "ds_read_b64_tr_b16 %3, %11 offset:%16\n\t" \
                "ds_read_b64_tr_b16 %4, %12 offset:%15\n\t" "ds_read_b64_tr_b16 %5, %12 offset:%16\n\t" \
                "ds_read_b64_tr_b16 %6, %13 offset:%15\n\t" "ds_read_b64_tr_b16 %7, %13 offset:%16\n\t" \
                "ds_read_b64_tr_b16 %8, %14 offset:%15\n\t" "ds_read_b64_tr_b16 %9, %14 offset:%16" \
                : "=&v"(T[0]), "=&v"(T[1]), "=&v"(T[2]), "=&v"(T[3]), "=&v"(T[4]), "=&v"(T[5]), "=&v"(T[6]), "=&v"(T[7]), "=&v"(T[8]), "=&v"(T[9]) \
                : "v"(va[0]), "v"(va[1]), "v"(va[2]), "v"(va[3]), "v"(va[4]), "i"(((DT) >> 1) * 64 + ((DT) & 1) * 8), "i"(((DT) >> 1) * 64 + ((DT) & 1) * 8 + 16 * KPITCH) : "memory")
#define TR_WAIT(T, N) asm volatile("s_waitcnt lgkmcnt(" #N ")" \
                : "+v"(T[0]), "+v"(T[1]), "+v"(T[2]), "+v"(T[3]), "+v"(T[4]), "+v"(T[5]), "+v"(T[6]), "+v"(T[7]), "+v"(T[8]), "+v"(T[9]) :: "memory")
        s16x4 ta[10], tb[10];
        TR_ISSUE(ta, 0);
#pragma unroll
        for (int dt = 0; dt < 8; dt += 2) {
            TR_ISSUE(tb, dt + 1);
            TR_WAIT(ta, 10);
            f32x4 acc0 = {0.f, 0.f, 0.f, 0.f};
#pragma unroll
            for (int pp = 0; pp < 5; ++pp) acc0 = __builtin_amdgcn_mfma_f32_16x16x32_bf16(__builtin_shufflevector(ta[2 * pp], ta[2 * pp + 1], 0, 1, 2, 3, 4, 5, 6, 7), pf[pp], acc0, 0, 0, 0);
            if (dt + 2 < 8) { TR_ISSUE(ta, dt + 2); TR_WAIT(tb, 10); } else { TR_WAIT(tb, 0); }
            f32x4 acc1 = {0.f, 0.f, 0.f, 0.f};
#pragma unroll
            for (int pp = 0; pp < 5; ++pp) acc1 = __builtin_amdgcn_mfma_f32_16x16x32_bf16(__builtin_shufflevector(tb[2 * pp], tb[2 * pp + 1], 0, 1, 2, 3, 4, 5, 6, 7), pf[pp], acc1, 0, 0, 0);
            {
                u32x4 o; o[0] = cvt_pk_bf16(acc0[0] * invl, acc0[1] * invl); o[1] = cvt_pk_bf16(acc0[2] * invl, acc0[3] * invl);
                o[2] = cvt_pk_bf16(acc1[0] * invl, acc1[1] * invl); o[3] = cvt_pk_bf16(acc1[2] * invl, acc1[3] * invl);
                if (!dry) *(u32x4*)(qp + 16 * dt + 8 * quad) = o;
            }
        }
#undef TR_ISSUE
#undef TR_WAIT
        if (quad == 0) LSE[((size_t)g * T_TOK + qrow) * 8 + h] = 0.6931471805599453f * (mx + log2f(lsum));
        if (!last) {
            __syncthreads();
            lstore((c + 1) & 1, kpre, vpre);
            __syncthreads();
        }
    }
}

#define XB_TMO      128
#define XB_XCNT(j)  (256  + 64 * (j))
#define XB_XSUB(j)  (1280 + 64 * (j))
#define XB_XGEN(j)  (2304 + 64 * (j))
#define XB_TOP      3328
#define XB_TOPGEN   3392
#define XCD_BAR_WORDS 3456
#define XB_SPIN_CAP (1u << 20)
__device__ __forceinline__ unsigned xb_ld(unsigned* p)              { return __hip_atomic_load(p, __ATOMIC_RELAXED, __HIP_MEMORY_SCOPE_AGENT); }
__device__ __forceinline__ unsigned xb_add(unsigned* p, unsigned v) { return __hip_atomic_fetch_add(p, v, __ATOMIC_RELAXED, __HIP_MEMORY_SCOPE_AGENT); }
__device__ __forceinline__ unsigned xb_xcc_id() { return (unsigned)__builtin_amdgcn_s_getreg((3 << 11) | 20) & 0xFu; }
#define XB_SPIN(cond, bar) do { unsigned _sp = 0; while (cond) { __builtin_amdgcn_s_sleep(1); \
    if ((++_sp & 255u) == 0u) { if (xb_ld(&(bar)[XB_TMO])) break; if (_sp > XB_SPIN_CAP) { atomicAdd(&(bar)[XB_TMO], 1u); break; } } } } while (0)
struct XcdBarrier { unsigned* bar; unsigned x; volatile LAS unsigned* st; };
__device__ __forceinline__ XcdBarrier xcd_barrier_post(unsigned* bar, volatile LAS unsigned* st) {
    XcdBarrier b; b.bar = bar; b.x = xb_xcc_id(); b.st = st;
    if (threadIdx.x == 0) (void)xb_add(&bar[XB_XCNT(b.x)], 1u);
    return b;
}
__device__ __forceinline__ void xcd_barrier_complete(unsigned* bar, unsigned x, unsigned& nloc, unsigned& nx) {
    const unsigned G = gridDim.x * gridDim.y * gridDim.z;
    unsigned sum, cnt, mine, sp = 0u;
    for (;;) {
        sum = 0u; cnt = 0u; mine = 0u;
#pragma unroll
        for (unsigned j = 0; j < 16; ++j) { const unsigned c = xb_ld(&bar[XB_XCNT(j)]); sum += c; cnt += (c > 0u) ? 1u : 0u; mine = (j == x) ? c : mine; }
        if (sum == G) break;
        __builtin_amdgcn_s_sleep(1);
        if ((++sp & 255u) == 0u) { if (xb_ld(&bar[XB_TMO])) break; if (sp > XB_SPIN_CAP) { atomicAdd(&bar[XB_TMO], 1u); break; } }
    }
    nloc = mine > 0u ? mine : 1u; nx = cnt > 0u ? cnt : 1u;
}
__device__ __forceinline__ void xcd_barrier(const XcdBarrier& b) {
    asm volatile("s_waitcnt vmcnt(0)" ::: "memory");
    __syncthreads();
    if (threadIdx.x == 0) {
        unsigned* bar = b.bar;
        __builtin_amdgcn_s_waitcnt(0);
        unsigned nloc = b.st[0], nx = b.st[1];
        if (nloc == 0u) { xcd_barrier_complete(bar, b.x, nloc, nx); b.st[0] = nloc; b.st[1] = nx; }
        const unsigned old = xb_add(&bar[XB_XSUB(b.x)], 1u);
        const unsigned gen = old / nloc;
        if (old + 1u == (gen + 1u) * nloc) {
            __builtin_amdgcn_fence(__ATOMIC_RELEASE, "agent");
            asm volatile("s_waitcnt vmcnt(0)" ::: "memory");
            const unsigned og = xb_add(&bar[XB_TOP], 1u);
            const unsigned tg = og / nx;
            if (og + 1u == (tg + 1u) * nx) xb_add(&bar[XB_TOPGEN], 1u);
            else XB_SPIN(xb_ld(&bar[XB_TOPGEN]) == tg, bar);
            __builtin_amdgcn_fence(__ATOMIC_ACQUIRE, "agent");
            xb_add(&bar[XB_XGEN(b.x)], 1u);
            asm volatile("s_waitcnt vmcnt(0)" ::: "memory");
        } else {
            XB_SPIN(xb_ld(&bar[XB_XGEN(b.x)]) == gen, bar);
            __builtin_amdgcn_fence(__ATOMIC_ACQUIRE, "agent");
            asm volatile("s_waitcnt vmcnt(0)" ::: "memory");
        }
    }
    __syncthreads();
}

__device__ __forceinline__ void run_phase(PP P, int ph, unsigned char* lds, bool dry) {
    int tid_ = threadIdx.x, bid_ = blockIdx.x;
    asm volatile("" : "+v"(tid_));
    asm volatile("" : "+s"(bid_));
    bf16_t* W = (bf16_t*)(P->ws + WS_W);
    bf16_t* arr = (bf16_t*)(P->ws + WS_ARR);
    bf16_t* Pb = (bf16_t*)(P->ws + WS_P);
    bf16_t* Lb = (bf16_t*)(P->ws + WS_L);
    bf16_t* A0 = arr; bf16_t* A1 = arr + ARR_E; bf16_t* A2 = arr + 2 * ARR_E; bf16_t* A3 = arr + 3 * ARR_E; bf16_t* A4 = arr + 4 * ARR_E; bf16_t* A5 = arr + 5 * ARR_E;
    LAS unsigned char* l3 = (LAS unsigned char*)lds;
    EpiArgs ea; ea.mode = 0; ea.pad_ = 0; ea.o0 = nullptr; ea.o1 = nullptr; ea.o2 = nullptr; ea.i0 = nullptr; ea.f0 = nullptr; ea.f1 = nullptr; ea.f2 = nullptr; ea.hout = P->out; ea.hin = P->out; ea.lse = nullptr;
    int kind = 0, pc_layer = -1; bool pc_zero = false, zeroL = false, gn = false; int scan_l = 0;
    const bf16_t* gA = nullptr; const bf16_t* gB = nullptr; int gK = 1024, nseg = 1, pm1 = 0, pn1 = 0, nN0 = 4, nN1 = 0;
    const float* hin = P->out; const float* ng = nullptr; const float* mu0 = nullptr; const float* mu1 = nullptr; bf16_t* X1 = nullptr;
    float* ssq = (float*)(P->ws + WS_SSQ);
    ea.ssq_out = nullptr; ea.ssq_in = ssq + 8 * T_TOK; ea.hb = A0; ea.hbin = A3;
    bf16_t* Lcur = Lb;
    bf16_t* X2 = nullptr; const float* mu2 = nullptr;
    bool ple2 = false; const bf16_t* gB2 = nullptr; EpiArgs eb = ea;
    int pm2 = 0, pn2 = 0, nN2 = 0;
    if (ph == 0) kind = 7;
    else if (ph <= 18) {
        const int l = (ph - 1) / 9, s = (ph - 1) % 9 + 1;
        const float* hl = (l == 0) ? P->in[0] : P->out;
        const float* mu = P->in[3] + l * 6 * 1024;
        bf16_t* Wl = W + l * RW_STRIDE;
        bf16_t* V = (l == 0) ? A4 : A5;
        bf16_t* X2l = (l == 0) ? A5 : (bf16_t*)(P->ws + WS_A6);
        if (l == 1) Lcur = W;
        hin = hl; ng = P->in[2] + l * 1024; scan_l = l;
        switch (s) {
        case 1: kind = 3; mu0 = mu; mu1 = mu + 1024; X1 = A1; break;
        case 2: kind = 1; ea.mode = M_SPLIT; ea.o0 = A2; gA = A0; gB = Wl + RW_WRK; nseg = 2; pm1 = 128; pn1 = 4; nN0 = 4; nN1 = 4; break;
        case 3: kind = 3; mu0 = mu + 2 * 1024; mu1 = mu + 4 * 1024; mu2 = mu + 5 * 1024; X1 = A1; X2 = X2l; break;
        case 4: kind = 1; ea.mode = M_VLW; ea.o0 = V; ea.o1 = Lcur; gA = A0; gB = Wl + RW_WVW; nseg = 3; pm1 = 128; pn1 = 5; nN0 = (l == 0 ? 4 : 5); nN1 = 1;
                pm2 = (l == 0) ? 640 : 768; pn2 = 6; nN2 = 1; break;
        case 5: kind = 5; break;
        case 6: kind = 3; mu0 = mu + 3 * 1024; gn = true; break;
        case 7: kind = 1; ea.mode = M_G; ea.o0 = A2; gA = A0; gB = Wl + RW_WG; break;
        case 8: kind = 2; ea.mode = M_OUT; ea.hin = hl; ea.hb = A3; ea.ssq_out = ssq + (2 * l) * T_TOK; gA = A2; gB = Wl + RW_WO; pc_layer = l; break;
        default: kind = 1; ea.mode = M_PGATE; ea.o0 = A1; ea.ssq_in = ssq + (2 * l) * T_TOK; gA = A3; gB = W + PLE_BASE + l * PLE_STRIDE;
                 ple2 = true; eb = ea; eb.mode = M_PLE; eb.i0 = A1; eb.ssq_in = nullptr; eb.ssq_out = ssq + (2 * l + 1) * T_TOK; gB2 = W + PLE_BASE + l * PLE_STRIDE + PLE_WP; break;
        }
    } else if (ph == 19) { kind = 1; ea.mode = M_SPLIT; ea.o0 = A4; ea.ssq_in = ssq + 3 * T_TOK; gA = A0; gB = W + KV_BASE; nN0 = 8; }
    else if (ph <= 29) {
        const int q = (ph - 20) / 5, s = (ph - 20) % 5 + 1;
        const int gl = 2 + q;
        bf16_t* Wa = W + ATT_BASE + q * ATT_STRIDE;
        const float* sin_ = ssq + (q == 0 ? 3 : 5) * T_TOK;
        switch (s) {
        case 1: kind = 1; ea.mode = M_SPLIT; ea.o0 = A1; ea.ssq_in = sin_; gA = A0; gB = Wa; nN0 = 12; pc_layer = gl; break;
        case 2: kind = 6; break;
        case 3: kind = 1; ea.mode = M_AGATE; ea.o0 = A1; ea.ssq_in = sin_; ea.lse = (const float*)(P->ws + WS_LSE); gA = A0; gB = Wa + (size_t)3072 * 1024; break;
        case 4: kind = 2; ea.mode = M_OUT; ea.hb = A3; ea.ssq_out = ssq + (4 + 2 * q) * T_TOK; gA = A1; gB = Wa + ATT_WO; break;
        default: kind = 1; ea.mode = M_PGATE; ea.o0 = A2; ea.ssq_in = ssq + (4 + 2 * q) * T_TOK; gA = A3; gB = W + PLE_BASE + gl * PLE_STRIDE;
                 ple2 = true; eb = ea; eb.mode = M_PLE; eb.i0 = A2; eb.ssq_in = nullptr; eb.ssq_out = ssq + (5 + 2 * q) * T_TOK; gB2 = W + PLE_BASE + gl * PLE_STRIDE + PLE_WP; break;
        }
    } else kind = 8;

    if (kind == 1 || kind == 2) {
        pg8::Gemm g{gA, gB, gK};
        pg8::SegOrder S; S.nseg = nseg; S.G = gridDim.x; S.c = bid_; S.pm1 = pm1; S.pn1 = pn1; S.nN0 = nN0; S.nN1 = nN1; S.pm2 = pm2; S.pn2 = pn2; S.nN2 = nN2;
#ifndef NO_GP
        const int npass = ple2 ? 2 : 1;
        for (int pass = 0; pass < npass; ++pass) {
            Epi<true> E; E.a = ea;
            if (pass == 1) {
                asm volatile("s_waitcnt vmcnt(0)" ::: "memory");
                __syncthreads();
                g.A = Pb; g.Bt = gB2; g.K = 256; E.a = eb;
            }
            pg8::gemm_phase<Epi<true>, pg8::SegOrder>(l3, g, S, E, tid_);
        }
#endif
    } else if (kind == 3) {
        prep_shift(hin, ng, mu0, mu1, mu2, A0, X1, X2, tid_, bid_, A5, A1, P->in[17] + scan_l * 1024, P->in[18] + scan_l * 1024, gn ? A2 : nullptr);
    } else if (kind == 4) {
        prep_plain(hin, ng, A0, tid_, bid_);
    }
#ifndef NO_SCAN
    else if (kind == 5) scan_phase(P, scan_l, (float*)lds, tid_, bid_, Lcur);
#endif
#ifndef NO_ATTN
    else if (kind == 6) attn_phase(P, lds, tid_, bid_, dry);
#endif
    else if (kind == 7) convert_phase(P, (float*)lds, tid_, bid_);
    else if (kind == 8) final_norm(P->out, P->in[28], ssq + 7 * T_TOK, tid_, bid_);
    if (pc_layer >= 0) pconv(P, pc_layer, false, tid_, bid_);
}

__global__ void __launch_bounds__(512, 2) yoco_mega(Params P) {
    extern __shared__ __attribute__((aligned(16))) unsigned char lds[];
    cg::grid_group grid = cg::this_grid();
    volatile LAS unsigned* st = (volatile LAS unsigned*)((LAS unsigned char*)lds + (LDS_BYTES - 16));
    if (threadIdx.x == 0) { st[0] = 0u; st[1] = 0u; }
    __syncthreads();
    const XcdBarrier xb = xcd_barrier_post((unsigned*)(P.ws + WS_BAR), st);
    for (int ph = P.ph_lo; ph < P.ph_hi; ++ph) {
        PP Pk = (PP)__builtin_amdgcn_kernarg_segment_ptr();
        asm volatile("" : "+s"(Pk));
        int nrep = 1;
        if (PROBE_MODE == 1 && (ph == 2 || ph == 4)) nrep = 2;
        if (PROBE_MODE == 2 && (ph == 1 || ph == 3 || ph == 6)) nrep = 2;
        if (PROBE_MODE == 3 && ph == 5) nrep = 2;
        for (int rep = 0; rep < nrep; ++rep) {
            run_phase(Pk, ph, lds, rep + 1 < nrep);
            if (rep + 1 < nrep) xcd_barrier(xb);
        }
        if (ph + 1 < P.ph_hi) { if (ph == 0) grid.sync(); else xcd_barrier(xb); }
    }
}

extern "C" void kernel_launch(void* const* d_in, const int* in_sizes, int n_in, void* d_out, int out_size, void* d_ws, size_t ws_size, hipStream_t stream) {
    static int grid = 0;
    if (grid == 0) {
        int dev = 0, cus = 0, per_cu = 0;
        hipGetDevice(&dev);
        hipDeviceGetAttribute(&cus, hipDeviceAttributeMultiprocessorCount, dev);
        if (hipFuncSetAttribute((const void*)yoco_mega, hipFuncAttributeMaxDynamicSharedMemorySize, LDS_BYTES) != hipSuccess) fprintf(stderr, "hipFuncSetAttribute failed\n");
        hipOccupancyMaxActiveBlocksPerMultiprocessor(&per_cu, (const void*)yoco_mega, 512, LDS_BYTES);
        if (per_cu < 1) fprintf(stderr, "occupancy query says %d blocks per CU\n", per_cu);
        (void)hipGetLastError();
        grid = cus > 0 ? cus : 256;
        if (grid > 256) grid = 256;
        if (ws_size < 512 * MiB) fprintf(stderr, "workspace too small: %zu\n", ws_size);
    }
    Params p;
    __builtin_memset(&p, 0, sizeof(p));
    for (int i = 0; i < 29; ++i) p.in[i] = (const float*)d_in[i];
    p.out = (float*)d_out; p.ws = (unsigned char*)d_ws; p.ph_lo = 0; p.ph_hi = NPH;
    if (hipMemsetAsync((char*)d_ws + WS_BAR, 0, XCD_BAR_WORDS * 4, stream) != hipSuccess) fprintf(stderr, "memset failed\n");
    void* args[] = {&p};
    hipError_t e = hipLaunchCooperativeKernel((const void*)yoco_mega, dim3(grid), dim3(512), args, LDS_BYTES, stream);
    if (e != hipSuccess) fprintf(stderr, "cooperative launch failed: %s (grid %d)\n", hipGetErrorString(e), grid);
}
```

```cpp
#include <hip/hip_runtime.h>
#include <hip/hip_cooperative_groups.h>
#include <cstdio>
namespace cg = cooperative_groups;

#define LAS __attribute__((address_space(3)))
typedef unsigned short bf16_t;
typedef short bf16x8 __attribute__((ext_vector_type(8)));
typedef short s16x4 __attribute__((ext_vector_type(4)));
typedef float f32x4 __attribute__((ext_vector_type(4)));
typedef unsigned u32x4 __attribute__((ext_vector_type(4)));
typedef unsigned u32x2 __attribute__((ext_vector_type(2)));

constexpr int T_TOK = 32768, DM = 1024, SEQ = 4096;
constexpr size_t ARR_E = (size_t)T_TOK * DM;
constexpr size_t MiB = 1048576;
constexpr size_t WS_W = 0, WS_BAR = 60 * MiB, WS_SSQ = 60 * MiB + 65536, WS_ARR = 62 * MiB, WS_P = 446 * MiB, WS_L = 462 * MiB, WS_LSE = 462 * MiB, ARR_B = 64 * MiB;
constexpr size_t WS_A6 = 446 * MiB;
constexpr int LDS_BYTES = 139264;
constexpr int NPH = 31;
constexpr int LP = 192;
constexpr int PROBE_MODE = 0;
constexpr size_t RW_STRIDE = 6815744, RW_WRK = 0, RW_WVW = 2097152, RW_WA1 = 3670016, RW_W2C = 3932160, RW_WG = 4718592, RW_WO = 5767168;
constexpr size_t PLE_BASE = 13631488, PLE_STRIDE = 1310720, PLE_WP = 1048576;
constexpr size_t KV_BASE = 18874368, ATT_BASE = 20971520, ATT_STRIDE = 5242880, ATT_WO = 4194304;

struct Params {
    const float* in[29];
    float* out;
    unsigned char* ws;
    int ph_lo, ph_hi;
};

typedef const __attribute__((address_space(4))) Params* PP;

typedef __bf16 bf16x2_t __attribute__((ext_vector_type(2)));
typedef float f32x2_t __attribute__((ext_vector_type(2)));
__device__ __forceinline__ unsigned cvt_pk_bf16(float lo, float hi) { const f32x2_t v = {lo, hi}; return __builtin_bit_cast(unsigned, __builtin_convertvector(v, bf16x2_t)); }
__device__ __forceinline__ float bf_lo(unsigned u) { return __uint_as_float(u << 16); }
__device__ __forceinline__ float bf_hi(unsigned u) { return __uint_as_float(u & 0xffff0000u); }
__device__ __forceinline__ float sigmoidf_(float z) { return __builtin_amdgcn_rcpf(1.0f + __builtin_amdgcn_exp2f(-1.4426950408889634f * z)); }
__device__ __forceinline__ float siluf_(float z) { return z * __builtin_amdgcn_rcpf(1.0f + __builtin_amdgcn_exp2f(-1.4426950408889634f * z)); }
__device__ __forceinline__ float dpp_xor1(float v) { return __builtin_bit_cast(float, __builtin_amdgcn_update_dpp(0, __builtin_bit_cast(int, v), 0xB1, 0xf, 0xf, false)); }
__device__ __forceinline__ float dpp_xor2(float v) { return __builtin_bit_cast(float, __builtin_amdgcn_update_dpp(0, __builtin_bit_cast(int, v), 0x4E, 0xf, 0xf, false)); }
__device__ __forceinline__ float dpp_hmir(float v) { return __builtin_bit_cast(float, __builtin_amdgcn_update_dpp(0, __builtin_bit_cast(int, v), 0x141, 0xf, 0xf, false)); }
__device__ __forceinline__ float dpp_mir(float v) { return __builtin_bit_cast(float, __builtin_amdgcn_update_dpp(0, __builtin_bit_cast(int, v), 0x140, 0xf, 0xf, false)); }
__device__ __forceinline__ float sum16d(float v) { v += dpp_xor1(v); v += dpp_xor2(v); v += dpp_hmir(v); v += dpp_mir(v); return v; }
__device__ __forceinline__ float wave_sum(float v) {
#pragma unroll
    for (int o = 32; o >= 1; o >>= 1) v += __shfl_xor(v, o, 64);
    return v;
}
__device__ __forceinline__ float sum16(float v) {
    v += __shfl_xor(v, 1, 64); v += __shfl_xor(v, 2, 64); v += __shfl_xor(v, 4, 64); v += __shfl_xor(v, 8, 64); return v;
}

namespace pg8 {
constexpr int BM = 256, BK = 64, HALF = 128, HTB = HALF * BK * 2, NXCD = 8, WGM = 8;
__device__ __forceinline__ int lds_byte(int r, int c) { const int st = (r >> 4) * 2 + (c >> 5), rr = r & 15, cc = c & 31, ob = rr * 64 + cc * 2; return st * 1024 + (ob ^ (((ob >> 9) & 1) << 5)); }
__device__ __forceinline__ void stage_rc(int b, int& R, int& C) { const int st = b / 1024, sb = b % 1024, swz = sb ^ (((sb >> 9) & 1) << 5); R = (st >> 1) * 16 + swz / 64; C = (st & 1) * 32 + (swz % 64) / 2; }
__device__ __forceinline__ int perm32(int rho) { const int n = rho >> 4, i = rho & 15; return 8 * (i >> 2) + 4 * n + (i & 3); }
struct Unit { int pm, pn; };
struct Gemm { const bf16_t* A; const bf16_t* Bt; int K; };

struct SegOrder {
    int nseg, G, c;
    int pm1, pn1, pm2, pn2, nN0, nN1, nN2;
    __device__ __forceinline__ bool next(int i, Unit& u) const {
        int L = i * G + c;
        int s = 0;
        const int u0 = 128 * nN0, u1 = 128 * nN1;
        if (L >= u0) { if (nseg < 2) return false; L -= u0; s = 1;
            if (L >= u1) { if (nseg < 3) return false; L -= u1; s = 2; if (L >= 128 * nN2) return false; } }
        const int nM = 128, nn = (s == 0) ? nN0 : (s == 1 ? nN1 : nN2), nwg = nM * nn;
        int wgid = L; { const int q = nwg / NXCD, r = nwg % NXCD, xcd = wgid % NXCD, off = wgid / NXCD; wgid = (xcd < r ? xcd * (q + 1) : r * (q + 1) + (xcd - r) * q) + off; }
        const int nig = WGM * nn, gid = wgid / nig, fm = gid * WGM, gsz = (nM - fm) < WGM ? (nM - fm) : WGM;
        u.pm = ((s == 0) ? 0 : (s == 1 ? pm1 : pm2)) + fm + ((wgid % nig) % gsz); u.pn = ((s == 0) ? 0 : (s == 1 ? pn1 : pn2)) + (wgid % nig) / gsz; return true;
    }
};

template <class Epi, class Sched>
__device__ __forceinline__ void gemm_phase(LAS unsigned char* lds, const Gemm g, const Sched& S, const Epi& E, int tid_) {
    const int tid = tid_, wid = __builtin_amdgcn_readfirstlane(tid >> 6), lane = tid & 63, wr = wid >> 2, wc = wid & 3, fr = lane & 15, fq = lane >> 4;
    const int K = g.K, nt = K / BK;
    unsigned voffA[2], voffB[2];
#pragma unroll
    for (int i = 0; i < 2; ++i) { int R, C; stage_rc(tid * 16 + i * 8192, R, C); const int Rb = Epi::PERM ? ((R & ~31) + perm32(R & 31)) : R;
        voffA[i] = (unsigned)(R * K + C) * 2u; voffB[i] = (unsigned)(Rb * K + C) * 2u; }
    const size_t kstep = (size_t)(BK * 2);
    const size_t hstep = (size_t)HALF * K * 2;
    const size_t tstep = 2 * hstep;
    const unsigned ldsw = (unsigned)wid * 1024u;
    const int aoff = lds_byte(wr * 64 + fr, fq * 8), boff = lds_byte(wc * 32 + fr, fq * 8);
#define PG8_SA(b, h) (((b) * 2 + (h)) * HTB)
#define PG8_SB(b, h) ((4 + (b) * 2 + (h)) * HTB)
#define PG8_STAGE(bufoff, gbase, voff) do { _Pragma("unroll") for (int _i = 0; _i < 2; ++_i) \
        __builtin_amdgcn_global_load_lds((const unsigned*)((const char*)(gbase) + (voff)[_i]), (LAS unsigned*)(lds + (bufoff) + ldsw + _i * 8192), 16, 0, 0); } while (0)
#define PG8_LDA(dst, b, h) do { _Pragma("unroll") for (int m = 0; m < 4; ++m) _Pragma("unroll") for (int k = 0; k < 2; ++k) dst[m][k] = *(const LAS bf16x8*)(lds + PG8_SA(b, h) + aoff + m * 2048 + k * 1024); } while (0)
#define PG8_LDB(dst, b, h) do { _Pragma("unroll") for (int n = 0; n < 2; ++n) _Pragma("unroll") for (int k = 0; k < 2; ++k) dst[n][k] = *(const LAS bf16x8*)(lds + PG8_SB(b, h) + boff + n * 2048 + k * 1024); } while (0)
#define PG8_MMA(ai, bj, At, Bt) do { __builtin_amdgcn_s_setprio(1); _Pragma("unroll") for (int m = 0; m < 4; ++m) _Pragma("unroll") for (int n = 0; n < 2; ++n) _Pragma("unroll") for (int k = 0; k < 2; ++k) \
        acc[ai][bj][m][n] = __builtin_amdgcn_mfma_f32_16x16x32_bf16(Bt[n][k], At[m][k], acc[ai][bj][m][n], 0, 0, 0); __builtin_amdgcn_s_setprio(0); } while (0)
#define PG8_WAIT_V(n) asm volatile("s_waitcnt vmcnt(" #n ")" ::: "memory")
#define PG8_WAIT_L(n) asm volatile("s_waitcnt lgkmcnt(" #n ")" ::: "memory")
#define PG8_BAR __builtin_amdgcn_s_barrier()
#define PG8_SCHED __builtin_amdgcn_sched_barrier(0)
    Unit cur, nxt; int ui = 0;
    if (!S.next(0, cur)) return;
    f32x4 acc[2][2][4][2];
#pragma unroll
    for (int a = 0; a < 2; ++a)
#pragma unroll
        for (int b = 0; b < 2; ++b)
#pragma unroll
            for (int m = 0; m < 4; ++m)
#pragma unroll
                for (int n = 0; n < 2; ++n) acc[a][b][m][n] = (f32x4){0.f, 0.f, 0.f, 0.f};
    bf16x8 At[4][2], B0[2][2], B1[2][2];
    const char* cA = (const char*)g.A + (size_t)cur.pm * tstep; const char* cB = (const char*)g.Bt + (size_t)cur.pn * tstep;
    PG8_STAGE(PG8_SB(0, 0), cB, voffB); PG8_STAGE(PG8_SA(0, 0), cA, voffA); PG8_STAGE(PG8_SB(0, 1), cB + hstep, voffB); PG8_STAGE(PG8_SA(0, 1), cA + hstep, voffA);
    if (wr == 1) PG8_BAR;
    PG8_WAIT_V(4); PG8_BAR;
    PG8_STAGE(PG8_SB(1, 0), cB + kstep, voffB); PG8_STAGE(PG8_SA(1, 0), cA + kstep, voffA); PG8_STAGE(PG8_SB(1, 1), cB + hstep + kstep, voffB);
    PG8_WAIT_V(6); PG8_BAR;
    for (;;) {
        const bool has_next = S.next(ui + 1, nxt);
        const char* nA = has_next ? (const char*)g.A + (size_t)nxt.pm * tstep : cA; const char* nB = has_next ? (const char*)g.Bt + (size_t)nxt.pn * tstep : cB;
        for (int t = 0; t < nt; t += 2) {
            const bool last = (t == nt - 2);
            const char* a1 = cA + (size_t)(t + 1) * kstep;
            const char* a2 = last ? nA : cA + (size_t)(t + 2) * kstep; const char* b2 = last ? nB : cB + (size_t)(t + 2) * kstep;
            const char* a3 = a2 + kstep; const char* b3 = b2 + kstep;
            PG8_LDB(B0, 0, 0); PG8_SCHED; PG8_LDA(At, 0, 0); PG8_STAGE(PG8_SA(1, 1), a1 + hstep, voffA);
            PG8_WAIT_L(8); PG8_BAR; PG8_WAIT_L(0); PG8_MMA(0, 0, At, B0); PG8_BAR; PG8_SCHED;
            PG8_LDB(B1, 0, 1); PG8_STAGE(PG8_SB(0, 0), b2, voffB);
            PG8_BAR; PG8_WAIT_L(0); PG8_MMA(0, 1, At, B1); PG8_BAR;
            PG8_LDA(At, 0, 1); PG8_STAGE(PG8_SA(0, 0), a2, voffA);
            PG8_BAR; PG8_WAIT_L(0); PG8_MMA(1, 0, At, B0); PG8_BAR; PG8_SCHED;
            PG8_STAGE(PG8_SB(0, 1), b2 + hstep, voffB);
            PG8_WAIT_V(6); PG8_BAR; PG8_MMA(1, 1, At, B1); PG8_BAR;
            PG8_LDB(B0, 1, 0); PG8_SCHED; PG8_LDA(At, 1, 0); PG8_STAGE(PG8_SA(0, 1), a2 + hstep, voffA);
            PG8_WAIT_L(8); PG8_BAR; PG8_WAIT_L(0); PG8_MMA(0, 0, At, B0); PG8_BAR; PG8_SCHED;
            PG8_LDB(B1, 1, 1); PG8_STAGE(PG8_SB(1, 0), b3, voffB);
            PG8_BAR; PG8_WAIT_L(0); PG8_MMA(0, 1, At, B1); PG8_BAR;
            PG8_LDA(At, 1, 1); PG8_STAGE(PG8_SA(1, 0), a3, voffA);
            PG8_BAR; PG8_WAIT_L(0); PG8_MMA(1, 0, At, B0); PG8_BAR; PG8_SCHED;
            PG8_STAGE(PG8_SB(1, 1), b3 + hstep, voffB);
            PG8_WAIT_V(6); PG8_BAR; PG8_MMA(1, 1, At, B1); PG8_BAR;
        }
        E(acc, cur, wr, wc, fr, fq);
        if (!has_next) break;
#pragma unroll
        for (int a = 0; a < 2; ++a)
#pragma unroll
            for (int b = 0; b < 2; ++b)
#pragma unroll
                for (int m = 0; m < 4; ++m)
#pragma unroll
                    for (int n = 0; n < 2; ++n) acc[a][b][m][n] = (f32x4){0.f, 0.f, 0.f, 0.f};
        cur = nxt; cA = nA; cB = nB; ++ui;
    }
    PG8_WAIT_V(0);
    if (wr == 0) PG8_BAR;
    PG8_BAR;
#undef PG8_SA
#undef PG8_SB
#undef PG8_STAGE
#undef PG8_LDA
#undef PG8_LDB
#undef PG8_MMA
#undef PG8_WAIT_V
#undef PG8_WAIT_L
#undef PG8_BAR
#undef PG8_SCHED
}
}

enum { M_SPLIT = 0, M_VLW, M_LA, M_L2, M_G, M_PGATE, M_AGATE, M_OUT, M_PLE };
struct EpiArgs {
    int mode, pad_;
    bf16_t* o0; bf16_t* o1; bf16_t* o2; const bf16_t* i0;
    const float* f0; const float* f1; const float* f2;
    float* hout; const float* hin; const float* lse;
    float* ssq_out; const float* ssq_in; bf16_t* hb; const bf16_t* hbin;
};

__device__ __forceinline__ void store8(bf16_t* p, const f32x4& v0, const f32x4& v1) {
    u32x4 o; o[0] = cvt_pk_bf16(v0[0], v0[1]); o[1] = cvt_pk_bf16(v0[2], v0[3]); o[2] = cvt_pk_bf16(v1[0], v1[1]); o[3] = cvt_pk_bf16(v1[2], v1[3]);
    *(u32x4*)p = o;
}
__device__ __forceinline__ void load8(const bf16_t* p, f32x4& v0, f32x4& v1) {
    const u32x4 o = *(const u32x4*)p;
    v0[0] = bf_lo(o[0]); v0[1] = bf_hi(o[0]); v0[2] = bf_lo(o[1]); v0[3] = bf_hi(o[1]);
    v1[0] = bf_lo(o[2]); v1[1] = bf_hi(o[2]); v1[2] = bf_lo(o[3]); v1[3] = bf_hi(o[3]);
}

template <bool PERM_> struct Epi {
    static constexpr bool PERM = PERM_;
    EpiArgs a;
    struct Pre { float rs; float ls[6]; u32x4 q[6]; };
    template <int MODE> __device__ __forceinline__ Pre loadpre(int row, int pn, int colt) const {
        Pre p; p.rs = 1.0f;
        if constexpr (MODE == M_SPLIT || MODE == M_PGATE || MODE == M_AGATE) p.rs = a.ssq_in[row];
        if constexpr (MODE == M_G) {
#pragma unroll
            for (int bj = 0; bj < 2; ++bj) p.q[bj] = *(const u32x4*)(a.o0 + (size_t)row * DM + pn * 256 + bj * 128 + colt);
        }
        if constexpr (MODE == M_AGATE) {
#pragma unroll
            for (int bj = 0; bj < 2; ++bj) {
                const int c = pn * 256 + bj * 128 + colt, head = c >> 7;
#pragma unroll
                for (int g = 0; g < 3; ++g) {
                    p.ls[bj * 3 + g] = a.lse[((size_t)g * T_TOK + row) * 8 + head];
                    p.q[bj * 3 + g] = *(const u32x4*)(a.o0 + (size_t)g * ARR_E + (size_t)row * DM + c);
                }
            }
        }
        return p;
    }
    __device__ __forceinline__ static void unpack8(const u32x4& o, f32x4& v0, f32x4& v1) {
        v0[0] = bf_lo(o[0]); v0[1] = bf_hi(o[0]); v0[2] = bf_lo(o[1]); v0[3] = bf_hi(o[1]);
        v1[0] = bf_lo(o[2]); v1[1] = bf_hi(o[2]); v1[2] = bf_lo(o[3]); v1[3] = bf_hi(o[3]);
    }
    template <int MODE> __device__ __forceinline__ void epi8(int row, int pn, int col0, int bj, f32x4 v0, f32x4 v1, const Pre& pre) const {
        if constexpr (MODE == M_SPLIT) {
            bf16_t* dst = a.o0 + (size_t)(pn >> 2) * ARR_E + (size_t)row * DM + (pn & 3) * 256 + col0;
            store8(dst, v0, v1);
        } else if constexpr (MODE == M_VLW) {
            if (pn < 4) { store8(a.o0 + (size_t)row * DM + pn * 256 + col0, v0, v1); }
            else if (pn == 4) { if (col0 < 32) store8(a.o1 + (size_t)row * LP + 128 + col0, v0, v1); }
            else if (pn == 5) { if (col0 < 64) {
#pragma unroll
                    for (int i = 0; i < 4; ++i) { v0[i] = tanhf(v0[i]); v1[i] = tanhf(v1[i]); }
                    store8(a.o1 + (size_t)row * LP + col0, v0, v1); } }
            else { if (col0 < 64) store8(a.o1 + (size_t)row * LP + 64 + col0, v0, v1); }
        } else if constexpr (MODE == M_G) {
            bf16_t* dst = a.o0 + (size_t)row * DM + pn * 256 + col0;
            f32x4 x0, x1; unpack8(pre.q[bj], x0, x1);
#pragma unroll
            for (int i = 0; i < 4; ++i) { v0[i] = x0[i] * siluf_(v0[i]); v1[i] = x1[i] * siluf_(v1[i]); }
            store8(dst, v0, v1);
        } else if constexpr (MODE == M_PGATE) {
#pragma unroll
            for (int i = 0; i < 4; ++i) { v0[i] = sigmoidf_(v0[i]); v1[i] = sigmoidf_(v1[i]); }
            store8(a.o0 + (size_t)row * DM + pn * 256 + col0, v0, v1);
        } else if constexpr (MODE == M_AGATE) {
            const int c = pn * 256 + col0;
            const float l0 = pre.ls[bj * 3], l1 = pre.ls[bj * 3 + 1], l2 = pre.ls[bj * 3 + 2];
            const float mx = fmaxf(l0, fmaxf(l1, l2));
            float w0 = __builtin_amdgcn_exp2f(1.4426950408889634f * (l0 - mx)), w1 = __builtin_amdgcn_exp2f(1.4426950408889634f * (l1 - mx)), w2 = __builtin_amdgcn_exp2f(1.4426950408889634f * (l2 - mx));
            const float inv = __builtin_amdgcn_rcpf(w0 + w1 + w2); w0 *= inv; w1 *= inv; w2 *= inv;
            bf16_t* p0 = a.o0 + (size_t)row * DM + c;
            f32x4 x0, x1, y0, y1, z0, z1; unpack8(pre.q[bj * 3], x0, x1); unpack8(pre.q[bj * 3 + 1], y0, y1); unpack8(pre.q[bj * 3 + 2], z0, z1);
#pragma unroll
            for (int i = 0; i < 4; ++i) {
                v0[i] = (w0 * x0[i] + w1 * y0[i] + w2 * z0[i]) * siluf_(v0[i]);
                v1[i] = (w0 * x1[i] + w1 * y1[i] + w2 * z1[i]) * siluf_(v1[i]); }
            store8(p0, v0, v1);
        }
    }
    template <int MODE, int NB> __device__ __forceinline__ void runp(const f32x4 (&acc)[2][2][4][2], const pg8::Unit& u, int rowbase, int wc, int fq) const {
        const int colt = wc * 32 + 8 * fq;
#pragma unroll
        for (int b0 = 0; b0 < 8; b0 += NB) {
            Pre pre[NB];
#pragma unroll
            for (int j = 0; j < NB; ++j) pre[j] = loadpre<MODE>(rowbase + ((b0 + j) >> 2) * 128 + ((b0 + j) & 3) * 16, u.pn, colt);
#pragma unroll
            for (int j = 0; j < NB; ++j) {
                const int ai = (b0 + j) >> 2, m = (b0 + j) & 3;
                const int row = rowbase + ai * 128 + m * 16;
                float rs = 1.0f;
                if constexpr (MODE == M_SPLIT || MODE == M_PGATE || MODE == M_AGATE) rs = rsqrtf(pre[j].rs * (1.0f / 1024.0f) + 1e-6f);
#pragma unroll
                for (int bj = 0; bj < 2; ++bj) epi8<MODE>(row, u.pn, bj * 128 + colt, bj, acc[ai][bj][m][0] * rs, acc[ai][bj][m][1] * rs, pre[j]);
            }
        }
    }
    struct PreF { f32x4 hv[4]; u32x4 gg[2]; u32x4 hq[2]; };
    template <int MODE> __device__ __forceinline__ PreF loadpref(int row, int pn, int colt) const {
        PreF p;
#pragma unroll
        for (int bj = 0; bj < 2; ++bj) {
            const size_t off = (size_t)row * DM + pn * 256 + bj * 128 + colt;
            if constexpr (MODE == M_OUT) { p.hv[bj * 2] = *(const f32x4*)(a.hin + off); p.hv[bj * 2 + 1] = *(const f32x4*)(a.hin + off + 4); }
            else { p.hq[bj] = *(const u32x4*)(a.hbin + off); p.gg[bj] = *(const u32x4*)(a.i0 + off); }
        }
        return p;
    }
    template <int MODE, int NB> __device__ __forceinline__ void runf(const f32x4 (&acc)[2][2][4][2], const pg8::Unit& u, int rowbase, int wc, int fq) const {
        const int colt = wc * 32 + 8 * fq;
#pragma unroll
        for (int b0 = 0; b0 < 8; b0 += NB) {
            PreF pre[NB];
#pragma unroll
            for (int j = 0; j < NB; ++j) pre[j] = loadpref<MODE>(rowbase + ((b0 + j) >> 2) * 128 + ((b0 + j) & 3) * 16, u.pn, colt);
#pragma unroll
            for (int j = 0; j < NB; ++j) {
                const int ai = (b0 + j) >> 2, m = (b0 + j) & 3;
                const int row = rowbase + ai * 128 + m * 16;
                float ss = 0.f;
#pragma unroll
                for (int bj = 0; bj < 2; ++bj) {
                    const size_t off = (size_t)row * DM + u.pn * 256 + bj * 128 + colt;
                    const f32x4 v0 = acc[ai][bj][m][0], v1 = acc[ai][bj][m][1];
                    f32x4 o0, o1;
                    if constexpr (MODE == M_OUT) {
                        o0 = pre[j].hv[bj * 2] + v0; o1 = pre[j].hv[bj * 2 + 1] + v1;
                    } else {
                        f32x4 g0, g1, h0, h1; unpack8(pre[j].gg[bj], g0, g1); unpack8(pre[j].hq[bj], h0, h1);
                        o0 = h0 + v0 * g0; o1 = h1 + v1 * g1;
                        *(f32x4*)(a.hout + off) = o0; *(f32x4*)(a.hout + off + 4) = o1;
                    }
                    if (a.hb) store8(a.hb + off, o0, o1);
                    ss += (o0[0] * o0[0] + o0[1] * o0[1]) + (o0[2] * o0[2] + o0[3] * o0[3]) + (o1[0] * o1[0] + o1[1] * o1[1]) + (o1[2] * o1[2] + o1[3] * o1[3]);
                }
                if (a.ssq_out) { ss += __shfl_xor(ss, 16, 64); ss += __shfl_xor(ss, 32, 64);
                    if (fq == 0) atomicAdd(a.ssq_out + row, ss); }
            }
        }
    }
    __device__ __forceinline__ void operator()(const f32x4 (&acc)[2][2][4][2], const pg8::Unit& u, int wr, int wc, int fr, int fq) const {
        const int rowbase = (u.pm & 127) * 256 + wr * 64 + fr;
        if constexpr (PERM_) {
            switch (a.mode) {
            case M_SPLIT: runp<M_SPLIT, 8>(acc, u, rowbase, wc, fq); break;
            case M_VLW: runp<M_VLW, 8>(acc, u, rowbase, wc, fq); break;
            case M_G: runp<M_G, 4>(acc, u, rowbase, wc, fq); break;
            case M_PGATE: runp<M_PGATE, 8>(acc, u, rowbase, wc, fq); break;
            case M_OUT: runf<M_OUT, 2>(acc, u, rowbase, wc, fq); break;
            case M_PLE: runf<M_PLE, 2>(acc, u, rowbase, wc, fq); break;
            default: runp<M_AGATE, 1>(acc, u, rowbase, wc, fq); break;
            }
        }
    }
};

struct CJob { const float* src; bf16_t* dst; int K, N, nrows, ldd, koff; const float* ksc; };
__device__ __forceinline__ void conv_job(const CJob& j, int& cum, float* tile, int tid_, int bid_) {
    const int lane = tid_ & 63, w = tid_ >> 6, GW = gridDim.x * 8;
    float* tl = tile + w * (64 * 65);
    const int tn = j.nrows >> 6, tk = j.ldd >> 6, ntiles = tn * tk;
    const int start = ((bid_ * 8 + w) - (cum % GW) + GW) % GW;
    for (int t = start; t < ntiles; t += GW) {
        const int n0 = (t / tk) * 64, k0 = (t % tk) * 64;
        f32x4 v[16];
#pragma unroll
        for (int i = 0; i < 16; ++i) {
            const int idx = lane + 64 * i, kl = idx >> 4, n4 = (idx & 15) * 4;
            const int k = k0 + kl - j.koff, n = n0 + n4;
            v[i] = (f32x4){0.f, 0.f, 0.f, 0.f};
            if (k >= 0 && k < j.K && n < j.N) { v[i] = *(const f32x4*)(j.src + (size_t)k * j.N + n); if (j.ksc) v[i] = v[i] * j.ksc[k]; }
        }
#pragma unroll
        for (int i = 0; i < 16; ++i) {
            const int idx = lane + 64 * i, kl = idx >> 4, n4 = (idx & 15) * 4;
#pragma unroll
            for (int e = 0; e < 4; ++e) tl[kl * 65 + n4 + e] = v[i][e];
        }
        __builtin_amdgcn_wave_barrier();
#pragma unroll
        for (int jj = 0; jj < 8; ++jj) {
            const int idx = lane + 64 * jj, nl = idx >> 3, k8 = (idx & 7) * 8;
            float x[8];
#pragma unroll
            for (int e = 0; e < 8; ++e) x[e] = tl[(k8 + e) * 65 + nl];
            u32x4 o; o[0] = cvt_pk_bf16(x[0], x[1]); o[1] = cvt_pk_bf16(x[2], x[3]); o[2] = cvt_pk_bf16(x[4], x[5]); o[3] = cvt_pk_bf16(x[6], x[7]);
            *(u32x4*)(j.dst + (size_t)(n0 + nl) * j.ldd + k0 + k8) = o;
        }
        __builtin_amdgcn_wave_barrier();
    }
    cum += ntiles;
}
__device__ __forceinline__ void convert_phase(PP P, float* tile, int tid_, int bid_) {
    bf16_t* W = (bf16_t*)(P->ws + WS_W);
    int cum = 0;
    { float* ssq = (float*)(P->ws + WS_SSQ); for (int i = bid_ * 512 + tid_; i < 9 * T_TOK; i += gridDim.x * 512) ssq[i] = (i < 8 * T_TOK) ? 0.f : 1023.999f; }
    for (int l = 0; l < 2; ++l) {
        bf16_t* base = W + l * RW_STRIDE;
        const float* rkvg = P->in[4] + (size_t)l * 4 * 1048576;
        CJob j;
        j = {rkvg, base + RW_WRK, 1024, 1024, 1024, 1024, 0, nullptr}; conv_job(j, cum, tile, tid_, bid_);
        j = {rkvg + 1048576, base + RW_WRK + 1048576, 1024, 1024, 1024, 1024, 0, nullptr}; conv_job(j, cum, tile, tid_, bid_);
        j = {rkvg + 2 * 1048576, base + RW_WVW, 1024, 1024, 1024, 1024, 0, nullptr}; conv_job(j, cum, tile, tid_, bid_);
        j = {P->in[12], base + RW_WVW + 1048576, 1024, l == 0 ? 0 : 32, 256, 1024, 0, nullptr}; conv_job(j, cum, tile, tid_, bid_);
        j = {P->in[6] + (size_t)l * 65536, base + RW_WVW + 1048576 + 262144, 1024, 64, 256, 1024, 0, nullptr}; conv_job(j, cum, tile, tid_, bid_);
        j = {P->in[9] + (size_t)l * 65536, base + RW_WA1, 1024, 64, 256, 1024, 0, nullptr}; conv_job(j, cum, tile, tid_, bid_);
        j = {P->in[7] + (size_t)l * 65536, base + RW_W2C, 64, 1024, 1024, 256, 0, nullptr}; conv_job(j, cum, tile, tid_, bid_);
        j = {P->in[10] + (size_t)l * 65536, base + RW_W2C + 262144, 64, 1024, 1024, 256, 64, nullptr}; conv_job(j, cum, tile, tid_, bid_);
        j = {P->in[13], base + RW_W2C + 524288, 32, l == 0 ? 0 : 1024, 1024, 256, 128, nullptr}; conv_job(j, cum, tile, tid_, bid_);
        j = {rkvg + 3 * 1048576, base + RW_WG, 1024, 1024, 1024, 1024, 0, nullptr}; conv_job(j, cum, tile, tid_, bid_);
        j = {P->in[19] + (size_t)l * 1048576, base + RW_WO, 1024, 1024, 1024, 1024, 0, nullptr}; conv_job(j, cum, tile, tid_, bid_);
    }
    for (int i = 0; i < 4; ++i) {
        bf16_t* base = W + PLE_BASE + i * PLE_STRIDE;
        CJob j;
        j = {P->in[27] + (size_t)i * 1048576, base, 1024, 1024, 1024, 1024, 0, P->in[26] + i * 1024}; conv_job(j, cum, tile, tid_, bid_);
        j = {P->in[25] + (size_t)i * 262144, base + PLE_WP, 256, 1024, 1024, 256, 0, nullptr}; conv_job(j, cum, tile, tid_, bid_);
    }
    { CJob j = {P->in[21], W + KV_BASE, 1024, 2048, 2048, 1024, 0, nullptr}; conv_job(j, cum, tile, tid_, bid_); }
    for (int q = 0; q < 2; ++q) {
        bf16_t* base = W + ATT_BASE + q * ATT_STRIDE;
        CJob j;
        j = {P->in[23] + (size_t)q * 4194304, base, 1024, 4096, 4096, 1024, 0, P->in[22] + q * 1024}; conv_job(j, cum, tile, tid_, bid_);
        j = {P->in[24] + (size_t)q * 1048576, base + ATT_WO, 1024, 1024, 1024, 1024, 0, nullptr}; conv_job(j, cum, tile, tid_, bid_);
    }
}

__device__ __forceinline__ void pconv(PP P, int layer, bool zeroL, int tid_, int bid_) {
    const float* src = P->in[1] + (size_t)layer * T_TOK * 256;
    bf16_t* dst = (bf16_t*)(P->ws + WS_P);
    const size_t n8 = (size_t)T_TOK * 256 / 8, stride = (size_t)gridDim.x * 512;
    if (layer >= 0) for (size_t i = (size_t)bid_ * 512 + tid_; i < n8; i += 4 * stride) {
        f32x4 av[4], bv[4];
#pragma unroll
        for (int u = 0; u < 4; ++u) { const size_t ii = i + u * stride; if (ii < n8) { av[u] = *(const f32x4*)(src + ii * 8); bv[u] = *(const f32x4*)(src + ii * 8 + 4); } }
#pragma unroll
        for (int u = 0; u < 4; ++u) { const size_t ii = i + u * stride; if (ii < n8) store8(dst + ii * 8, av[u], bv[u]); }
    }
    if (zeroL) {
        bf16_t* L = (bf16_t*)(P->ws + WS_L);
        const size_t nz = (size_t)T_TOK * 16;
        for (size_t i = (size_t)bid_ * 512 + tid_; i < nz; i += stride) {
            const size_t row = i >> 4, cc = i & 15;
            *(u32x4*)(L + row * 256 + 128 + cc * 8) = (u32x4){0u, 0u, 0u, 0u};
        }
    }
}

__device__ __forceinline__ void load_row(const float* p, int lane, f32x4 (&r)[4]) {
#pragma unroll
    for (int i = 0; i < 4; ++i) r[i] = *(const f32x4*)(p + lane * 4 + 256 * i);
}
__device__ __forceinline__ float row_rstd(const f32x4 (&r)[4]) {
    float ss = 0.f;
#pragma unroll
    for (int i = 0; i < 4; ++i) ss += r[i][0] * r[i][0] + r[i][1] * r[i][1] + r[i][2] * r[i][2] + r[i][3] * r[i][3];
    ss = wave_sum(ss);
    return rsqrtf(ss * (1.0f / 1024.0f) + 1e-6f);
}
__device__ __forceinline__ void prep_shift(const float* hin, const float* g, const float* mu0, const float* mu1, const float* mu2, bf16_t* X0, bf16_t* X1, bf16_t* X2, int tid_, int bid_,
                                           const bf16_t* Yr, const bf16_t* Ad, const float* gng, const float* gnb, bf16_t* Yo) {
    const int lane = tid_ & 63, gw = bid_ * 8 + (tid_ >> 6);
    const int per = T_TOK / (gridDim.x * 8);
    f32x4 gv[4], m0[4], m1[4], m2[4], prev[4], row[4];
    load_row(g, lane, gv); load_row(mu0, lane, m0);
    if (X1) load_row(mu1, lane, m1);
    if (X2) load_row(mu2, lane, m2);
    const int t0 = gw * per;
    if ((t0 & (SEQ - 1)) == 0) {
#pragma unroll
        for (int i = 0; i < 4; ++i) prev[i] = (f32x4){0.f, 0.f, 0.f, 0.f};
    } else {
        load_row(hin + (size_t)(t0 - 1) * DM, lane, row);
        const float rs = row_rstd(row);
#pragma unroll
        for (int i = 0; i < 4; ++i) prev[i] = row[i] * rs * gv[i];
    }
    f32x4 rown[4];
    load_row(hin + (size_t)t0 * DM, lane, rown);
    f32x4 gng4[4], gnb4[4]; u32x2 yqn[4], aqn[4];
    if (Yo) {
        load_row(gng, lane, gng4); load_row(gnb, lane, gnb4);
#pragma unroll
        for (int i = 0; i < 4; ++i) { const size_t off = (size_t)t0 * DM + lane * 4 + 256 * i; yqn[i] = *(const u32x2*)(Yr + off); aqn[i] = *(const u32x2*)(Ad + off); }
    }
    for (int k = 0; k < per; ++k) {
        const int t = t0 + k;
#pragma unroll
        for (int i = 0; i < 4; ++i) row[i] = rown[i];
        load_row(hin + (size_t)(k + 1 < per ? t + 1 : t) * DM, lane, rown);
        u32x2 yqc[4], aqc[4];
        if (Yo) {
#pragma unroll
            for (int i = 0; i < 4; ++i) { yqc[i] = yqn[i]; aqc[i] = aqn[i];
                const size_t off = (size_t)(k + 1 < per ? t + 1 : t) * DM + lane * 4 + 256 * i; yqn[i] = *(const u32x2*)(Yr + off); aqn[i] = *(const u32x2*)(Ad + off); }
        }
        const float rs = row_rstd(row);
#pragma unroll
        for (int i = 0; i < 4; ++i) {
            const f32x4 xn = row[i] * rs * gv[i];
            const f32x4 xx = prev[i] - xn;
            const f32x4 a = xn + xx * m0[i];
            u32x2 o; o[0] = cvt_pk_bf16(a[0], a[1]); o[1] = cvt_pk_bf16(a[2], a[3]);
            *(u32x2*)(X0 + (size_t)t * DM + lane * 4 + 256 * i) = o;
            if (X1) {
                const f32x4 b = xn + xx * m1[i];
                u32x2 o2; o2[0] = cvt_pk_bf16(b[0], b[1]); o2[1] = cvt_pk_bf16(b[2], b[3]);
                *(u32x2*)(X1 + (size_t)t * DM + lane * 4 + 256 * i) = o2;
            }
            if (X2) {
                const f32x4 b = xn + xx * m2[i];
                u32x2 o2; o2[0] = cvt_pk_bf16(b[0], b[1]); o2[1] = cvt_pk_bf16(b[2], b[3]);
                *(u32x2*)(X2 + (size_t)t * DM + lane * 4 + 256 * i) = o2;
            }
            prev[i] = xn;
        }
        if (Yo) {
#pragma unroll
            for (int i = 0; i < 4; ++i) {
                const size_t off = (size_t)t * DM + lane * 4 + 256 * i;
                const u32x2 yq = yqc[i], aq = aqc[i];
                const f32x4 y4 = {bf_lo(yq[0]), bf_hi(yq[0]), bf_lo(yq[1]), bf_hi(yq[1])};
                const f32x4 a4 = {bf_lo(aq[0]), bf_hi(aq[0]), bf_lo(aq[1]), bf_hi(aq[1])};
                float sm = (y4[0] + y4[1]) + (y4[2] + y4[3]);
                sm = sum16d(sm);
                const float mean = sm * (1.0f / 64.0f);
                const f32x4 yc = y4 - mean;
                float vs = yc[0] * yc[0] + yc[1] * yc[1] + yc[2] * yc[2] + yc[3] * yc[3];
                vs = sum16d(vs);
                const float r2 = rsqrtf(vs * (1.0f / 64.0f) + 64e-5f);
                const f32x4 ov = yc * r2 * gng4[i] + gnb4[i] + a4;
                u32x2 o; o[0] = cvt_pk_bf16(ov[0], ov[1]); o[1] = cvt_pk_bf16(ov[2], ov[3]);
                *(u32x2*)(Yo + off) = o;
            }
        }
    }
}
__device__ __forceinline__ void prep_plain(const float* hin, const float* g, bf16_t* X0, int tid_, int bid_) {
    const int lane = tid_ & 63, gw = bid_ * 8 + (tid_ >> 6);
    const int per = T_TOK / (gridDim.x * 8);
    f32x4 gv[4], row[4];
    load_row(g, lane, gv);
    for (int k = 0; k < per; ++k) {
        const int t = gw * per + k;
        load_row(hin + (size_t)t * DM, lane, row);
        const float rs = row_rstd(row);
#pragma unroll
        for (int i = 0; i < 4; ++i) {
            const f32x4 a = row[i] * rs * gv[i];
            u32x2 o; o[0] = cvt_pk_bf16(a[0], a[1]); o[1] = cvt_pk_bf16(a[2], a[3]);
            *(u32x2*)(X0 + (size_t)t * DM + lane * 4 + 256 * i) = o;
        }
    }
}
__device__ __forceinline__ void final_norm(float* h, const float* g, const float* ssq, int tid_, int bid_) {
    const int lane = tid_ & 63, gw = bid_ * 8 + (tid_ >> 6);
    const int per = T_TOK / (gridDim.x * 8);
    f32x4 gv[4], r0[4], r1[4], r2[4];
    load_row(g, lane, gv);
    const int t0 = gw * per;
    load_row(h + (size_t)t0 * DM, lane, r0); float s0 = ssq[t0];
    load_row(h + (size_t)(t0 + 1) * DM, lane, r1); float s1 = ssq[t0 + 1];
    for (int k = 0; k < per; ++k) {
        const int t = t0 + k;
        const int tn = (k + 2 < per) ? t + 2 : t;
        load_row(h + (size_t)tn * DM, lane, r2); const float s2 = ssq[tn];
        const float rs = rsqrtf(s0 * (1.0f / 1024.0f) + 1e-6f);
#pragma unroll
        for (int i = 0; i < 4; ++i) *(f32x4*)(h + (size_t)t * DM + lane * 4 + 256 * i) = r0[i] * rs * gv[i];
#pragma unroll
        for (int i = 0; i < 4; ++i) { r0[i] = r1[i]; r1[i] = r2[i]; }
        s0 = s1; s1 = s2;
    }
}

constexpr int TC = 32;
typedef float f32x2 __attribute__((ext_vector_type(2)));
struct StepOps { f32x4 k0, k1, k2, k3, wa, wb, ba, bb, xa, xb; };
constexpr int VTP = TC + 4;
constexpr int SB_KR = 0, SB_WW = TC * 128, SB_BN = SB_WW + TC * 64, SB_KX = SB_BN + TC * 64, SB_VV = SB_KX + TC * 64, SB_ADD = SB_VV + 32 * VTP, SB_SC = SB_ADD + TC * 32, SB_SIZE = SB_SC + 2 * TC;
__device__ __forceinline__ void scan_phase(PP P, int l, float* L, int tid_, int bid_, const bf16_t* Lo) {
    float* s_y = L + 2 * SB_SIZE;
    unsigned char* s_w2 = (unsigned char*)(s_y + 2 * TC * 32);
    const int pair = bid_ >> 1, half = bid_ & 1;
    const int b = pair >> 4, h = pair & 15;
    const int tid = tid_, lane = tid & 63, w = tid >> 6, l15 = lane & 15, quad = lane >> 4;
    const bool prod = (w >= 4);
    const int ptid = tid & 255;
    const int tt = ptid >> 4, cgp = ptid & 15, ch = h * 64 + 4 * cgp;
    const bool own = (cgp >> 3) == half;
    bf16_t* arr = (bf16_t*)(P->ws + WS_ARR);
    const bf16_t* R = arr + 2 * ARR_E; const bf16_t* Kp = arr + 3 * ARR_E;
    const bf16_t* V = arr + (size_t)(l == 0 ? 4 : 5) * ARR_E; const bf16_t* Vf = arr + 4 * ARR_E;
    bf16_t* Yr = arr + 5 * ARR_E; bf16_t* Ad = arr + ARR_E;
    const f32x4 pkk = *(const f32x4*)(P->in[14] + l * 1024 + ch), pka = *(const f32x4*)(P->in[15] + l * 1024 + ch), prk = *(const f32x4*)(P->in[16] + l * 1024 + ch);
    const size_t rowbase = (size_t)b * SEQ;
    const int mt = w & 1, ntb = 2 * ((w >> 1) & 1);
    const bf16_t* W2 = (const bf16_t*)(P->ws + WS_W) + l * RW_STRIDE + RW_W2C;
    {
        const int rr = tid >> 3, pc = tid & 7;
        *(u32x4*)(s_w2 + rr * 144 + pc * 16) = *(const u32x4*)(W2 + (size_t)(h * 64 + rr) * 256 + pc * 8);
        *(u32x4*)(s_w2 + 9216 + rr * 144 + pc * 16) = *(const u32x4*)(W2 + (size_t)(1024 + h * 64 + rr) * 256 + 64 + pc * 8);
        if (tid < 256) { const int r2 = tid >> 2, p2 = tid & 3; *(u32x4*)(s_w2 + 18432 + r2 * 80 + p2 * 16) = *(const u32x4*)(W2 + (size_t)(2048 + h * 64 + r2) * 256 + 128 + p2 * 8); }
    }
    float w0c[2], a0c[2], v0c[2];
#pragma unroll
    for (int n2 = 0; n2 < 2; ++n2) {
        const int chn = h * 64 + 16 * (ntb + n2) + l15;
        w0c[n2] = P->in[5][l * 1024 + chn]; a0c[n2] = P->in[8][l * 1024 + chn]; v0c[n2] = P->in[11][chn];
    }
    u32x2 qr[2], qk[2], qv[2], qf[2];
    bf16x8 lw[2], la[2], lv;
    auto issue = [&](int c) {
#pragma unroll
        for (int u = 0; u < 2; ++u) {
            const size_t off = (rowbase + (size_t)c * TC + tt + 16 * u) * DM + ch;
            qr[u] = *(const u32x2*)(R + off); qk[u] = *(const u32x2*)(Kp + off);
            qv[u] = (u32x2){0u, 0u}; qf[u] = (u32x2){0u, 0u};
            if (own) { qv[u] = *(const u32x2*)(V + off); if (l) qf[u] = *(const u32x2*)(Vf + off); }
        }
        const bf16_t* lrow = Lo + (rowbase + (size_t)c * TC + 16 * mt + l15) * LP;
        lw[0] = *(const bf16x8*)(lrow + quad * 8); lw[1] = *(const bf16x8*)(lrow + 32 + quad * 8);
        la[0] = *(const bf16x8*)(lrow + 64 + quad * 8); la[1] = *(const bf16x8*)(lrow + 96 + quad * 8);
        lv = *(const bf16x8*)(lrow + 128 + quad * 8);
    };
    auto lora2 = [&](float* sb) {
#pragma unroll
        for (int n2 = 0; n2 < 2; ++n2) {
            f32x4 aw = {0.f, 0.f, 0.f, 0.f}, aa = {0.f, 0.f, 0.f, 0.f}, av = {0.f, 0.f, 0.f, 0.f};
            const int chl = 16 * (ntb + n2) + l15;
            const bf16x8 bw0 = *(const bf16x8*)(s_w2 + chl * 144 + quad * 16), bw1 = *(const bf16x8*)(s_w2 + chl * 144 + 64 + quad * 16);
            const bf16x8 ba0 = *(const bf16x8*)(s_w2 + 9216 + chl * 144 + quad * 16), ba1 = *(const bf16x8*)(s_w2 + 9216 + chl * 144 + 64 + quad * 16);
            aw = __builtin_amdgcn_mfma_f32_16x16x32_bf16(lw[0], bw0, aw, 0, 0, 0);
            aw = __builtin_amdgcn_mfma_f32_16x16x32_bf16(lw[1], bw1, aw, 0, 0, 0);
            aa = __builtin_amdgcn_mfma_f32_16x16x32_bf16(la[0], ba0, aa, 0, 0, 0);
            aa = __builtin_amdgcn_mfma_f32_16x16x32_bf16(la[1], ba1, aa, 0, 0, 0);
            if (l) { const bf16x8 bv0 = *(const bf16x8*)(s_w2 + 18432 + chl * 80 + quad * 16); av = __builtin_amdgcn_mfma_f32_16x16x32_bf16(lv, bv0, av, 0, 0, 0); }
#pragma unroll
            for (int e = 0; e < 4; ++e) {
                const int o = (16 * mt + 4 * quad + e) * 64 + chl;
                sb[SB_WW + o] = 0.60653066f * sigmoidf_(w0c[n2] + aw[e]);
                sb[SB_BN + o] = sigmoidf_(a0c[n2] + aa[e]);
                if (l) sb[SB_KX + o] = sigmoidf_(v0c[n2] + av[e]);
            }
        }
    };
    auto prep = [&](float* sb) {
#pragma unroll
        for (int u = 0; u < 2; ++u) {
            const int tk = tt + 16 * u;
            const int o = tk * 64 + 4 * cgp;
            f32x4 r4 = {bf_lo(qr[u][0]), bf_hi(qr[u][0]), bf_lo(qr[u][1]), bf_hi(qr[u][1])};
            f32x4 k4 = {bf_lo(qk[u][0]), bf_hi(qk[u][0]), bf_lo(qk[u][1]), bf_hi(qk[u][1])};
            f32x4 v4 = {bf_lo(qv[u][0]), bf_hi(qv[u][0]), bf_lo(qv[u][1]), bf_hi(qv[u][1])};
            const f32x4 e4 = *(const f32x4*)(sb + SB_WW + o), a4 = *(const f32x4*)(sb + SB_BN + o);
            if (l) {
                const f32x4 vf = {bf_lo(qf[u][0]), bf_hi(qf[u][0]), bf_lo(qf[u][1]), bf_hi(qf[u][1])};
                const f32x4 gm = *(const f32x4*)(sb + SB_KX + o);
                v4 = v4 + (vf - v4) * gm;
            }
            f32x4 w4, kkv, kx, bn, wrv;
            float ss = 0.f, br = 0.f, kr = 0.f, bo = 0.f;
#pragma unroll
            for (int i = 0; i < 4; ++i) { w4[i] = __builtin_amdgcn_exp2f(-1.4426950408889634f * e4[i]); kkv[i] = k4[i] * pkk[i]; ss += kkv[i] * kkv[i]; kx[i] = k4[i] * (1.0f + (a4[i] - 1.0f) * pka[i]); }
            ss = sum16d(ss);
            const float inv = __builtin_amdgcn_rsqf(fmaxf(ss, 1e-24f));
#pragma unroll
            for (int i = 0; i < 4; ++i) { kkv[i] *= inv; bn[i] = -(kkv[i] * a4[i]); wrv[i] = w4[i] * r4[i]; br += bn[i] * r4[i]; kr += kx[i] * r4[i]; bo += r4[i] * kx[i] * prk[i]; }
            br = sum16d(br); kr = sum16d(kr); bo = sum16d(bo);
            { float* kr = sb + SB_KR + tk * 128 + (cgp & 1) * 64 + (cgp >> 1) * 4;
              *(f32x4*)(kr) = (f32x4){kkv[0], wrv[0], kkv[1], wrv[1]};
              *(f32x4*)(kr + 32) = (f32x4){kkv[2], wrv[2], kkv[3], wrv[3]}; }
            *(f32x4*)(sb + SB_BN + o) = bn; *(f32x4*)(sb + SB_WW + o) = w4; *(f32x4*)(sb + SB_KX + o) = kx;
            if (own) { const int o2 = tk * 32 + 4 * (cgp & 7); *(f32x4*)(sb + SB_ADD + o2) = v4 * bo;
#pragma unroll
                for (int i = 0; i < 4; ++i) sb[SB_VV + (4 * (cgp & 7) + i) * VTP + tk] = v4[i]; }
            if (cgp == 0) { sb[SB_SC + tk * 2] = br; sb[SB_SC + tk * 2 + 1] = kr; }
        }
    };
    auto epilogue = [&](int c) {
        const float* sb = L + (c & 1) * SB_SIZE;
        const int tk = ptid >> 3, i4 = 4 * (ptid & 7);
        const f32x4 y4 = *(const f32x4*)(s_y + (c & 1) * TC * 32 + tk * 32 + i4), a4 = *(const f32x4*)(sb + SB_ADD + tk * 32 + i4);
        const size_t off = (rowbase + (size_t)c * TC + tk) * DM + h * 64 + 32 * half + i4;
        u32x2 oy, oa; oy[0] = cvt_pk_bf16(y4[0], y4[1]); oy[1] = cvt_pk_bf16(y4[2], y4[3]); oa[0] = cvt_pk_bf16(a4[0], a4[1]); oa[1] = cvt_pk_bf16(a4[2], a4[3]);
        *(u32x2*)(Yr + off) = oy;
        *(u32x2*)(Ad + off) = oa;
    };
    const int rl = 8 * (w & 3) + (lane >> 3), jc = lane & 7;
    f32x4 st = {0.f, 0.f, 0.f, 0.f}, su = {0.f, 0.f, 0.f, 0.f};
    auto steps16 = [&](const float* sb, float* sy, int t0) {
        auto ldstep = [&](int t) {
            StepOps s;
            s.k0 = *(const f32x4*)(sb + SB_KR + t * 128 + 4 * jc); s.k1 = *(const f32x4*)(sb + SB_KR + t * 128 + 32 + 4 * jc);
            s.k2 = *(const f32x4*)(sb + SB_KR + t * 128 + 64 + 4 * jc); s.k3 = *(const f32x4*)(sb + SB_KR + t * 128 + 96 + 4 * jc);
            s.wa = *(const f32x4*)(sb + SB_WW + t * 64 + 8 * jc); s.wb = *(const f32x4*)(sb + SB_WW + t * 64 + 8 * jc + 4);
            s.ba = *(const f32x4*)(sb + SB_BN + t * 64 + 8 * jc); s.bb = *(const f32x4*)(sb + SB_BN + t * 64 + 8 * jc + 4);
            s.xa = *(const f32x4*)(sb + SB_KX + t * 64 + 8 * jc); s.xb = *(const f32x4*)(sb + SB_KX + t * 64 + 8 * jc + 4);
            return s;
        };
        StepOps cur = ldstep(t0);
        for (int tb = t0; tb < t0 + 16; tb += 8) {
            const f32x4 va = *(const f32x4*)(sb + SB_VV + rl * VTP + tb), vb = *(const f32x4*)(sb + SB_VV + rl * VTP + tb + 4);
            const f32x4 c0 = *(const f32x4*)(sb + SB_SC + 2 * tb), c1 = *(const f32x4*)(sb + SB_SC + 2 * tb + 4), c2 = *(const f32x4*)(sb + SB_SC + 2 * tb + 8), c3 = *(const f32x4*)(sb + SB_SC + 2 * tb + 12);
            const float vis[8] = {va[0], va[1], va[2], va[3], vb[0], vb[1], vb[2], vb[3]};
            const float brs[8] = {c0[0], c0[2], c1[0], c1[2], c2[0], c2[2], c3[0], c3[2]};
            const float krs[8] = {c0[1], c0[3], c1[1], c1[3], c2[1], c2[3], c3[1], c3[3]};
            float yacc = 0.f;
#pragma unroll
            for (int u = 0; u < 8; ++u) {
                const int t = tb + u;
                const StepOps nxt = ldstep(t + 1 < TC ? t + 1 : TC - 1);
                const float vi = vis[u];
                f32x2 p = (f32x2){st[0], st[0]} * (f32x2){cur.k0[0], cur.k0[1]};
                f32x2 q = (f32x2){su[0], su[0]} * (f32x2){cur.k2[0], cur.k2[1]};
                p = (f32x2){st[1], st[1]} * (f32x2){cur.k0[2], cur.k0[3]} + p;
                q = (f32x2){su[1], su[1]} * (f32x2){cur.k2[2], cur.k2[3]} + q;
                p = (f32x2){st[2], st[2]} * (f32x2){cur.k1[0], cur.k1[1]} + p;
                q = (f32x2){su[2], su[2]} * (f32x2){cur.k3[0], cur.k3[1]} + q;
                p = (f32x2){st[3], st[3]} * (f32x2){cur.k1[2], cur.k1[3]} + p;
                q = (f32x2){su[3], su[3]} * (f32x2){cur.k3[2], cur.k3[3]} + q;
                p = p + q;
                float p1 = p[0], p2 = p[1];
                p1 += dpp_xor1(p1); p2 += dpp_xor1(p2);
                p1 += dpp_xor2(p1); p2 += dpp_xor2(p2);
                p1 += dpp_hmir(p1); p2 += dpp_hmir(p2);
                const float y = p2 + p1 * brs[u] + vi * krs[u];
                yacc = (jc == u) ? y : yacc;
                st = st * cur.wa + (cur.ba * p1 + cur.xa * vi);
                su = su * cur.wb + (cur.bb * p1 + cur.xb * vi);
                cur = nxt;
            }
            sy[(tb + jc) * 32 + rl] = yacc;
        }
    };
    constexpr int NCH = SEQ / TC;
    if (prod) issue(0);
    __syncthreads();
    if (prod) lora2(L);
    __syncthreads();
    if (prod) { prep(L); if (1 < NCH) issue(1); }
    __syncthreads();
    for (int c = 0; c < NCH; ++c) {
        float* sb = L + (c & 1) * SB_SIZE;
        float* sn = L + ((c + 1) & 1) * SB_SIZE;
        if (!prod) { __builtin_amdgcn_s_setprio(3); steps16(sb, s_y + (c & 1) * TC * 32, 0); __builtin_amdgcn_s_setprio(0); }
        else { if (c > 0) epilogue(c - 1); if (c + 1 < NCH) lora2(sn); }
        __syncthreads();
        if (!prod) { __builtin_amdgcn_s_setprio(3); steps16(sb, s_y + (c & 1) * TC * 32, 16); __builtin_amdgcn_s_setprio(0); }
        else if (c + 1 < NCH) { prep(sn); if (c + 2 < NCH) issue(c + 2); }
        __syncthreads();
    }
    if (prod) epilogue(NCH - 1);
}

constexpr int KPITCH = 272, VB_OFF = 256 * KPITCH;
__device__ __forceinline__ void attn_phase(PP P, unsigned char* lds, int tid_, int bid_, bool dry) {
    const int tid = tid_, lane = tid & 63, w = tid >> 6, l15 = lane & 15, quad = lane >> 4;
    bf16_t* arr = (bf16_t*)(P->ws + WS_ARR);
    bf16_t* Q = arr + ARR_E; const bf16_t* Kc = arr + 4 * ARR_E; const bf16_t* Vc = arr + 5 * ARR_E;
    float* LSE = (float*)(P->ws + WS_LSE);
    const float LOG2E = 1.4426950408889634f;
    const int bh = bid_ >> 2, sub = bid_ & 3, b = bh >> 3, h = bh & 7;
    const size_t rowb = (size_t)b * SEQ;
    const unsigned ldsbase = (unsigned)(size_t)(LAS unsigned char*)lds;
    const float sc = 0.08838834764831845f * LOG2E;
    const float sl = exp2f(-(float)(h + 1)) * LOG2E;
    u32x4 kpre[4], vpre[4];
    auto decode = [&](int s, int& g, int& r, int& c, bool& first, bool& last) {
        if (s < 8) { g = 0; r = 0; c = sub * 8 + s; first = (s == 0); last = (s == 7); }
        else if (s < 16) { g = 1; r = sub; c = s - 8; first = (s == 8); last = (s == 15); }
        else { g = 2; r = sub * 4 + ((s - 16) >> 1); c = (s - 16) & 1; first = (c == 0); last = (c == 1); }
    };
    const int qi = 16 * w + l15;
    auto qptr = [&](int g, int r, int c) -> bf16_t* {
        const int d = 1 << (2 * g);
        const size_t qrow = rowb + (size_t)(c * 128 + qi) * d + r;
        return Q + (size_t)g * ARR_E + qrow * DM + h * 128;
    };
    bf16x8 qn[4];
    {   int g, r, c; bool f, l; decode(0, g, r, c, f, l);
        const bf16_t* qp0 = qptr(g, r, c);
#pragma unroll
        for (int ks = 0; ks < 4; ++ks) qn[ks] = *(const bf16x8*)(qp0 + ks * 32 + quad * 8);
    }
    const int wodd = w & 1, pb = w & ~1;
    for (int s = 0; s < 24; ++s) {
        int g, r, c; bool first, last;
        decode(s, g, r, c, first, last);
        const int d = 1 << (2 * g);
        auto gload2 = [&](int blk, int dd, int rr, u32x4 (&kk)[4], u32x4 (&vv)[4]) {
#pragma unroll
            for (int i = 0; i < 4; ++i) {
                const int idx = tid + 512 * i, j = idx >> 4, cc = idx & 15;
                if (blk >= 0) {
                    const size_t off = (rowb + (size_t)(blk * 128 + j) * dd + rr) * DM + h * 128 + cc * 8;
                    kk[i] = *(const u32x4*)(Kc + off); vv[i] = *(const u32x4*)(Vc + off);
                } else { kk[i] = (u32x4){0u, 0u, 0u, 0u}; vv[i] = (u32x4){0u, 0u, 0u, 0u}; }
            }
        };
        auto gload = [&](int blk, u32x4 (&kk)[4], u32x4 (&vv)[4]) { gload2(blk, d, r, kk, vv); };
        auto lstore = [&](int slot, const u32x4 (&kk)[4], const u32x4 (&vv)[4]) {
#pragma unroll
            for (int i = 0; i < 4; ++i) {
                const int idx = tid + 512 * i, j = idx >> 4, cc = idx & 15;
                *(u32x4*)(lds + (slot * 128 + j) * KPITCH + cc * 16) = kk[i];
                *(u32x4*)(lds + VB_OFF + (slot * 128 + j) * KPITCH + cc * 16) = vv[i];
            }
        };
        if (first) {
            if (s == 0) gload(c, kpre, vpre);
            __syncthreads();
            lstore(c & 1, kpre, vpre);
            gload(c - 1, kpre, vpre); lstore((c - 1) & 1, kpre, vpre);
            __syncthreads();
        }
        bf16_t* qp = qptr(g, r, c);
        const size_t qrow = rowb + (size_t)(c * 128 + qi) * d + r;
        bf16x8 qf[4];
#pragma unroll
        for (int ks = 0; ks < 4; ++ks) qf[ks] = qn[ks];
        if (s + 1 < 24) {
            int g2, r2, c2; bool f2, l2; decode(s + 1, g2, r2, c2, f2, l2);
            const bf16_t* qp2 = qptr(g2, r2, c2);
#pragma unroll
            for (int ks = 0; ks < 4; ++ks) qn[ks] = *(const bf16x8*)(qp2 + ks * 32 + quad * 8);
        }
        if (!last) gload(c + 1, kpre, vpre);
        else if (s + 1 < 24) {
            int g2, r2, c2; bool f2, l2; decode(s + 1, g2, r2, c2, f2, l2);
            gload2(c2, 1 << (2 * g2), r2, kpre, vpre);
        }
        const int xr = (c & 1) ? 0 : 8;
        f32x4 sv[10];
#pragma unroll
        for (int tt = 0; tt < 10; ++tt) {
            f32x4 acc = {0.f, 0.f, 0.f, 0.f};
            const unsigned char* kb = lds + (16 * ((pb + tt) ^ xr) + l15) * KPITCH + quad * 16;
            const bool outside = (tt == 0) ? (wodd != 0) : ((tt == 9) ? (wodd == 0) : false);
            if (!outside) {
#pragma unroll
                for (int ks = 0; ks < 4; ++ks) {
                    const bf16x8 a = *(const bf16x8*)(kb + ks * 64);
                    acc = __builtin_amdgcn_mfma_f32_16x16x32_bf16(a, qf[ks], acc, 0, 0, 0);
                }
            }
            sv[tt] = acc;
        }
        const float b0 = -sl * (float)(128 + l15 + 16 * wodd - 4 * quad);
        const float sl16 = 16.0f * sl;
        float mx = -INFINITY;
#pragma unroll
        for (int tt = 0; tt < 10; ++tt) {
            const float bt = b0 + sl16 * (float)tt;
            const bool tile_ok = (c > 0) || (pb + tt >= 8);
#pragma unroll
            for (int e = 0; e < 4; ++e) {
                float sx = sv[tt][e] * sc + (bt + sl * (float)e);
                if (tt < 2 || tt > 7) {
                    const int delta = 128 + l15 + 16 * wodd - 16 * tt - 4 * quad - e;
                    sx = ((delta >= 0) && (delta <= 128) && tile_ok) ? sx : -INFINITY;
                } else {
                    sx = tile_ok ? sx : -INFINITY;
                }
                sv[tt][e] = sx; mx = fmaxf(mx, sx);
            }
        }
        mx = fmaxf(mx, __shfl_xor(mx, 16, 64)); mx = fmaxf(mx, __shfl_xor(mx, 32, 64));
        float lsum = 0.f;
#pragma unroll
        for (int tt = 0; tt < 10; ++tt)
#pragma unroll
            for (int e = 0; e < 4; ++e) { const float p = __builtin_amdgcn_exp2f(sv[tt][e] - mx); sv[tt][e] = p; lsum += p; }
        lsum += __shfl_xor(lsum, 16, 64); lsum += __shfl_xor(lsum, 32, 64);
        bf16x8 pf[5];
#pragma unroll
        for (int pp = 0; pp < 5; ++pp) {
            u32x4 o; o[0] = cvt_pk_bf16(sv[2 * pp][0], sv[2 * pp][1]); o[1] = cvt_pk_bf16(sv[2 * pp][2], sv[2 * pp][3]);
            o[2] = cvt_pk_bf16(sv[2 * pp + 1][0], sv[2 * pp + 1][1]); o[3] = cvt_pk_bf16(sv[2 * pp + 1][2], sv[2 * pp + 1][3]);
            pf[pp] = __builtin_bit_cast(bf16x8, o);
        }
        const float invl = __builtin_amdgcn_rcpf(lsum);
        unsigned va[5];
#pragma unroll
        for (int pp = 0; pp < 5; ++pp) va[pp] = ldsbase + VB_OFF + (16 * ((pb + 2 * pp) ^ xr) + 4 * quad + (l15 >> 2)) * KPITCH + 16 * (l15 & 3);
#define TR_ISSUE(T, DT) asm volatile( \
                "ds_read_b64_tr_b16 %0, %10 offset:%15\n\t" "ds_read_b64_tr_b16 %1, %10 offset:%16\n\t" \
                "ds_read_b64_tr_b16 %2, %11 offset:%15\n\t" "ds_read_b64_tr_b16 %3, %11 offset:%16\n\t" \
                "ds_read_b64_tr_b16 %4, %12 offset:%15\n\t" "ds_read_b64_tr_b16 %5, %12 offset:%16\n\t" \
                "ds_read_b64_tr_b16 %6, %13 offset:%15\n\t" "ds_read_b64_tr_b16 %7, %13 offset:%16\n\t" \
                "ds_read_b64_tr_b16 %8, %14 offset:%15\n\t" "ds_read_b64_tr_b16 %9, %14 offset:%16" \
                : "=&v"(T[0]), "=&v"(T[1]), "=&v"(T[2]), "=&v"(T[3]), "=&v"(T[4]), "=&v"(T[5]), "=&v"(T[6]), "=&v"(T[7]), "=&v"(T[8]), "=&v"(T[9]) \
                : "v"(va[0]), "v"(va[1]), "v"(va[2]), "v"(va[3]), "v"(va[4]), "i"(((DT) >> 1) * 64 + ((DT) & 1) * 8), "i"(((DT) >> 1) * 64 + ((DT) & 1) * 8 + 16 * KPITCH) : "memory")
#define TR_WAIT(T, N) asm volatile("s_waitcnt lgkmcnt(" #N ")" \
                : "+v"(T[0]), "+v"(T[1]), "+v"(T[2]), "+v"(T[3]), "+v"(T[4]), "+v"(T[5]), "+v"(T[6]), "+v"(T[7]), "+v"(T[8]), "+v"(T[9]) :: "memory")
        s16x4 ta[10], tb[10];
        TR_ISSUE(ta, 0);
#pragma unroll
        for (int dt = 0; dt < 8; dt += 2) {
            TR_ISSUE(tb, dt + 1);
            TR_WAIT(ta, 10);
            f32x4 acc0 = {0.f, 0.f, 0.f, 0.f};
#pragma unroll
            for (int pp = 0; pp < 5; ++pp) acc0 = __builtin_amdgcn_mfma_f32_16x16x32_bf16(__builtin_shufflevector(ta[2 * pp], ta[2 * pp + 1], 0, 1, 2, 3, 4, 5, 6, 7), pf[pp], acc0, 0, 0, 0);
            if (dt + 2 < 8) { TR_ISSUE(ta, dt + 2); TR_WAIT(tb, 10); } else { TR_WAIT(tb, 0); }
            f32x4 acc1 = {0.f, 0.f, 0.f, 0.f};
#pragma unroll
            for (int pp = 0; pp < 5; ++pp) acc1 = __builtin_amdgcn_mfma_f32_16x16x32_bf16(__builtin_shufflevector(tb[2 * pp], tb[2 * pp + 1], 0, 1, 2, 3, 4, 5, 6, 7), pf[pp], acc1, 0, 0, 0);
            {
                u32x4 o; o[0] = cvt_pk_bf16(acc0[0] * invl, acc0[1] * invl); o[1] = cvt_pk_bf16(acc0[2] * invl, acc0[3] * invl);
                o[2] = cvt_pk_bf16(acc1[0] * invl, acc1[1] * invl); o[3] = cvt_pk_bf16(acc1[2] * invl, acc1[3] * invl);
                if (!dry) *(u32x4*)(qp + 16 * dt + 8 * quad) = o;
            }
        }
#undef TR_ISSUE
#undef TR_WAIT
        if (quad == 0) LSE[((size_t)g * T_TOK + qrow) * 8 + h] = 0.6931471805599453f * (mx + log2f(lsum));
        if (!last) {
            __syncthreads();
            lstore((c + 1) & 1, kpre, vpre);
            __syncthreads();
        }
    }
}

#define XB_TMO      128
#define XB_XCNT(j)  (256  + 64 * (j))
#define XB_XSUB(j)  (1280 + 64 * (j))
#define XB_XGEN(j)  (2304 + 64 * (j))
#define XB_TOP      3328
#define XB_TOPGEN   3392
#define XCD_BAR_WORDS 3456
#define XB_SPIN_CAP (1u << 20)
__device__ __forceinline__ unsigned xb_ld(unsigned* p)              { return __hip_atomic_load(p, __ATOMIC_RELAXED, __HIP_MEMORY_SCOPE_AGENT); }
__device__ __forceinline__ unsigned xb_add(unsigned* p, unsigned v) { return __hip_atomic_fetch_add(p, v, __ATOMIC_RELAXED, __HIP_MEMORY_SCOPE_AGENT); }
__device__ __forceinline__ unsigned xb_xcc_id() { return (unsigned)__builtin_amdgcn_s_getreg((3 << 11) | 20) & 0xFu; }
#define XB_SPIN(cond, bar) do { unsigned _sp = 0; while (cond) { __builtin_amdgcn_s_sleep(1); \
    if ((++_sp & 255u) == 0u) { if (xb_ld(&(bar)[XB_TMO])) break; if (_sp > XB_SPIN_CAP) { atomicAdd(&(bar)[XB_TMO], 1u); break; } } } } while (0)
struct XcdBarrier { unsigned* bar; unsigned x; volatile LAS unsigned* st; };
__device__ __forceinline__ XcdBarrier xcd_barrier_post(unsigned* bar, volatile LAS unsigned* st) {
    XcdBarrier b; b.bar = bar; b.x = xb_xcc_id(); b.st = st;
    if (threadIdx.x == 0) (void)xb_add(&bar[XB_XCNT(b.x)], 1u);
    return b;
}
__device__ __forceinline__ void xcd_barrier_complete(unsigned* bar, unsigned x, unsigned& nloc, unsigned& nx) {
    const unsigned G = gridDim.x * gridDim.y * gridDim.z;
    unsigned sum, cnt, mine, sp = 0u;
    for (;;) {
        sum = 0u; cnt = 0u; mine = 0u;
#pragma unroll
        for (unsigned j = 0; j < 16; ++j) { const unsigned c = xb_ld(&bar[XB_XCNT(j)]); sum += c; cnt += (c > 0u) ? 1u : 0u; mine = (j == x) ? c : mine; }
        if (sum == G) break;
        __builtin_amdgcn_s_sleep(1);
        if ((++sp & 255u) == 0u) { if (xb_ld(&bar[XB_TMO])) break; if (sp > XB_SPIN_CAP) { atomicAdd(&bar[XB_TMO], 1u); break; } }
    }
    nloc = mine > 0u ? mine : 1u; nx = cnt > 0u ? cnt : 1u;
}
__device__ __forceinline__ void xcd_barrier(const XcdBarrier& b) {
    asm volatile("s_waitcnt vmcnt(0)" ::: "memory");
    __syncthreads();
    if (threadIdx.x == 0) {
        unsigned* bar = b.bar;
        __builtin_amdgcn_s_waitcnt(0);
        unsigned nloc = b.st[0], nx = b.st[1];
        if (nloc == 0u) { xcd_barrier_complete(bar, b.x, nloc, nx); b.st[0] = nloc; b.st[1] = nx; }
        const unsigned old = xb_add(&bar[XB_XSUB(b.x)], 1u);
        const unsigned gen = old / nloc;
        if (old + 1u == (gen + 1u) * nloc) {
            __builtin_amdgcn_fence(__ATOMIC_RELEASE, "agent");
            asm volatile("s_waitcnt vmcnt(0)" ::: "memory");
            const unsigned og = xb_add(&bar[XB_TOP], 1u);
            const unsigned tg = og / nx;
            if (og + 1u == (tg + 1u) * nx) xb_add(&bar[XB_TOPGEN], 1u);
            else XB_SPIN(xb_ld(&bar[XB_TOPGEN]) == tg, bar);
            __builtin_amdgcn_fence(__ATOMIC_ACQUIRE, "agent");
            xb_add(&bar[XB_XGEN(b.x)], 1u);
            asm volatile("s_waitcnt vmcnt(0)" ::: "memory");
        } else {
            XB_SPIN(xb_ld(&bar[XB_XGEN(b.x)]) == gen, bar);
            __builtin_amdgcn_fence(__ATOMIC_ACQUIRE, "agent");
            asm volatile("s_waitcnt vmcnt(0)" ::: "memory");
        }
    }
    __syncthreads();
}

__device__ __forceinline__ void run_phase(PP P, int ph, unsigned char* lds, bool dry) {
    int tid_ = threadIdx.x, bid_ = blockIdx.x;
    asm volatile("" : "+v"(tid_));
    asm volatile("" : "+s"(bid_));
    bf16_t* W = (bf16_t*)(P->ws + WS_W);
    bf16_t* arr = (bf16_t*)(P->ws + WS_ARR);
    bf16_t* Pb = (bf16_t*)(P->ws + WS_P);
    bf16_t* Lb = (bf16_t*)(P->ws + WS_L);
    bf16_t* A0 = arr; bf16_t* A1 = arr + ARR_E; bf16_t* A2 = arr + 2 * ARR_E; bf16_t* A3 = arr + 3 * ARR_E; bf16_t* A4 = arr + 4 * ARR_E; bf16_t* A5 = arr + 5 * ARR_E;
    LAS unsigned char* l3 = (LAS unsigned char*)lds;
    EpiArgs ea; ea.mode = 0; ea.pad_ = 0; ea.o0 = nullptr; ea.o1 = nullptr; ea.o2 = nullptr; ea.i0 = nullptr; ea.f0 = nullptr; ea.f1 = nullptr; ea.f2 = nullptr; ea.hout = P->out; ea.hin = P->out; ea.lse = nullptr;
    int kind = 0, pc_layer = -1; bool pc_zero = false, zeroL = false, gn = false; int scan_l = 0;
    const bf16_t* gA = nullptr; const bf16_t* gB = nullptr; int gK = 1024, nseg = 1, pm1 = 0, pn1 = 0, nN0 = 4, nN1 = 0;
    const float* hin = P->out; const float* ng = nullptr; const float* mu0 = nullptr; const float* mu1 = nullptr; bf16_t* X1 = nullptr;
    float* ssq = (float*)(P->ws + WS_SSQ);
    ea.ssq_out = nullptr; ea.ssq_in = ssq + 8 * T_TOK; ea.hb = A0; ea.hbin = A3;
    bf16_t* Lcur = Lb;
    bf16_t* X2 = nullptr; const float* mu2 = nullptr;
    bool ple2 = false; const bf16_t* gB2 = nullptr; EpiArgs eb = ea;
    int pm2 = 0, pn2 = 0, nN2 = 0;
    if (ph == 0) kind = 7;
    else if (ph <= 18) {
        const int l = (ph - 1) / 9, s = (ph - 1) % 9 + 1;
        const float* hl = (l == 0) ? P->in[0] : P->out;
        const float* mu = P->in[3] + l * 6 * 1024;
        bf16_t* Wl = W + l * RW_STRIDE;
        bf16_t* V = (l == 0) ? A4 : A5;
        bf16_t* X2l = (l == 0) ? A5 : (bf16_t*)(P->ws + WS_A6);
        if (l == 1) Lcur = W;
        hin = hl; ng = P->in[2] + l * 1024; scan_l = l;
        switch (s) {
        case 1: kind = 3; mu0 = mu; mu1 = mu + 1024; X1 = A1; break;
        case 2: kind = 1; ea.mode = M_SPLIT; ea.o0 = A2; gA = A0; gB = Wl + RW_WRK; nseg = 2; pm1 = 128; pn1 = 4; nN0 = 4; nN1 = 4; break;
        case 3: kind = 3; mu0 = mu + 2 * 1024; mu1 = mu + 4 * 1024; mu2 = mu + 5 * 1024; X1 = A1; X2 = X2l; break;
        case 4: kind = 1; ea.mode = M_VLW; ea.o0 = V; ea.o1 = Lcur; gA = A0; gB = Wl + RW_WVW; nseg = 3; pm1 = 128; pn1 = 5; nN0 = (l == 0 ? 4 : 5); nN1 = 1;
                pm2 = (l == 0) ? 640 : 768; pn2 = 6; nN2 = 1; break;
        case 5: kind = 5; break;
        case 6: kind = 3; mu0 = mu + 3 * 1024; gn = true; break;
        case 7: kind = 1; ea.mode = M_G; ea.o0 = A2; gA = A0; gB = Wl + RW_WG; break;
        case 8: kind = 2; ea.mode = M_OUT; ea.hin = hl; ea.hb = A3; ea.ssq_out = ssq + (2 * l) * T_TOK; gA = A2; gB = Wl + RW_WO; pc_layer = l; break;
        default: kind = 1; ea.mode = M_PGATE; ea.o0 = A1; ea.ssq_in = ssq + (2 * l) * T_TOK; gA = A3; gB = W + PLE_BASE + l * PLE_STRIDE;
                 ple2 = true; eb = ea; eb.mode = M_PLE; eb.i0 = A1; eb.ssq_in = nullptr; eb.ssq_out = (l == 0) ? nullptr : ssq + (2 * l + 1) * T_TOK; if (l == 0) eb.hb = nullptr; gB2 = W + PLE_BASE + l * PLE_STRIDE + PLE_WP; break;
        }
    } else if (ph == 19) { kind = 1; ea.mode = M_SPLIT; ea.o0 = A4; ea.ssq_in = ssq + 3 * T_TOK; gA = A0; gB = W + KV_BASE; nN0 = 8; }
    else if (ph <= 29) {
        const int q = (ph - 20) / 5, s = (ph - 20) % 5 + 1;
        const int gl = 2 + q;
        bf16_t* Wa = W + ATT_BASE + q * ATT_STRIDE;
        const float* sin_ = ssq + (q == 0 ? 3 : 5) * T_TOK;
        switch (s) {
        case 1: kind = 1; ea.mode = M_SPLIT; ea.o0 = A1; ea.ssq_in = sin_; gA = A0; gB = Wa; nN0 = 12; pc_layer = gl; break;
        case 2: kind = 6; break;
        case 3: kind = 1; ea.mode = M_AGATE; ea.o0 = A1; ea.ssq_in = sin_; ea.lse = (const float*)(P->ws + WS_LSE); gA = A0; gB = Wa + (size_t)3072 * 1024; break;
        case 4: kind = 2; ea.mode = M_OUT; ea.hb = A3; ea.ssq_out = ssq + (4 + 2 * q) * T_TOK; gA = A1; gB = Wa + ATT_WO; break;
        default: kind = 1; ea.mode = M_PGATE; ea.o0 = A2; ea.ssq_in = ssq + (4 + 2 * q) * T_TOK; gA = A3; gB = W + PLE_BASE + gl * PLE_STRIDE;
                 ple2 = true; eb = ea; eb.mode = M_PLE; eb.i0 = A2; eb.ssq_in = nullptr; eb.ssq_out = ssq + (5 + 2 * q) * T_TOK; gB2 = W + PLE_BASE + gl * PLE_STRIDE + PLE_WP; break;
        }
    } else kind = 8;

    if (kind == 1 || kind == 2) {
        pg8::Gemm g{gA, gB, gK};
        pg8::SegOrder S; S.nseg = nseg; S.G = gridDim.x; S.c = bid_; S.pm1 = pm1; S.pn1 = pn1; S.nN0 = nN0; S.nN1 = nN1; S.pm2 = pm2; S.pn2 = pn2; S.nN2 = nN2;
#ifndef NO_GP
        const int npass = ple2 ? 2 : 1;
        for (int pass = 0; pass < npass; ++pass) {
            Epi<true> E; E.a = ea;
            if (pass == 1) {
                asm volatile("s_waitcnt vmcnt(0)" ::: "memory");
                __syncthreads();
                g.A = Pb; g.Bt = gB2; g.K = 256; E.a = eb;
            }
            pg8::gemm_phase<Epi<true>, pg8::SegOrder>(l3, g, S, E, tid_);
        }
#endif
    } else if (kind == 3) {
        prep_shift(hin, ng, mu0, mu1, mu2, A0, X1, X2, tid_, bid_, A5, A1, P->in[17] + scan_l * 1024, P->in[18] + scan_l * 1024, gn ? A2 : nullptr);
    } else if (kind == 4) {
        prep_plain(hin, ng, A0, tid_, bid_);
    }
#ifndef NO_SCAN
    else if (kind == 5) scan_phase(P, scan_l, (float*)lds, tid_, bid_, Lcur);
#endif
#ifndef NO_ATTN
    else if (kind == 6) attn_phase(P, lds, tid_, bid_, dry);
#endif
    else if (kind == 7) convert_phase(P, (float*)lds, tid_, bid_);
    else if (kind == 8) final_norm(P->out, P->in[28], ssq + 7 * T_TOK, tid_, bid_);
    if (pc_layer >= 0) pconv(P, pc_layer, false, tid_, bid_);
}

__global__ void __launch_bounds__(512, 2) yoco_mega(Params P) {
    extern __shared__ __attribute__((aligned(16))) unsigned char lds[];
    cg::grid_group grid = cg::this_grid();
    volatile LAS unsigned* st = (volatile LAS unsigned*)((LAS unsigned char*)lds + (LDS_BYTES - 16));
    if (threadIdx.x == 0) { st[0] = 0u; st[1] = 0u; }
    __syncthreads();
    const XcdBarrier xb = xcd_barrier_post((unsigned*)(P.ws + WS_BAR), st);
    for (int ph = P.ph_lo; ph < P.ph_hi; ++ph) {
        PP Pk = (PP)__builtin_amdgcn_kernarg_segment_ptr();
        asm volatile("" : "+s"(Pk));
        int nrep = 1;
        if (PROBE_MODE == 1 && (ph == 2 || ph == 4)) nrep = 2;
        if (PROBE_MODE == 2 && (ph == 1 || ph == 3 || ph == 6)) nrep = 2;
        if (PROBE_MODE == 3 && ph == 5) nrep = 2;
        for (int rep = 0; rep < nrep; ++rep) {
            run_phase(Pk, ph, lds, rep + 1 < nrep);
            if (rep + 1 < nrep) xcd_barrier(xb);
        }
        if (ph + 1 < P.ph_hi) { if (ph == 0) grid.sync(); else xcd_barrier(xb); }
    }
}

extern "C" void kernel_launch(void* const* d_in, const int* in_sizes, int n_in, void* d_out, int out_size, void* d_ws, size_t ws_size, hipStream_t stream) {
    static int grid = 0;
    if (grid == 0) {
        int dev = 0, cus = 0, per_cu = 0;
        hipGetDevice(&dev);
        hipDeviceGetAttribute(&cus, hipDeviceAttributeMultiprocessorCount, dev);
        if (hipFuncSetAttribute((const void*)yoco_mega, hipFuncAttributeMaxDynamicSharedMemorySize, LDS_BYTES) != hipSuccess) fprintf(stderr, "hipFuncSetAttribute failed\n");
        hipOccupancyMaxActiveBlocksPerMultiprocessor(&per_cu, (const void*)yoco_mega, 512, LDS_BYTES);
        if (per_cu < 1) fprintf(stderr, "occupancy query says %d blocks per CU\n", per_cu);
        (void)hipGetLastError();
        grid = cus > 0 ? cus : 256;
        if (grid > 256) grid = 256;
        if (ws_size < 512 * MiB) fprintf(stderr, "workspace too small: %zu\n", ws_size);
    }
    Params p;
    __builtin_memset(&p, 0, sizeof(p));
    for (int i = 0; i < 29; ++i) p.in[i] = (const float*)d_in[i];
    p.out = (float*)d_out; p.ws = (unsigned char*)d_ws; p.ph_lo = 0; p.ph_hi = NPH;
    if (hipMemsetAsync((char*)d_ws + WS_BAR, 0, XCD_BAR_WORDS * 4, stream) != hipSuccess) fprintf(stderr, "memset failed\n");
    void* args[] = {&p};
    hipError_t e = hipLaunchCooperativeKernel((const void*)yoco_mega, dim3(grid), dim3(512), args, LDS_BYTES, stream);
    if (e != hipSuccess) fprintf(stderr, "cooperative launch failed: %s (grid %d)\n", hipGetErrorString(e), grid);
}
```
